# Optimizing an MI355X kernel written in HIP

```python
import jax, jax.numpy as jnp
from jax import lax
import numpy as np

D_MODEL = 1024
BATCH = 4
SEQ = 8192
DEPTH = 1

N_MEM = 256
ATTN_HEADS = 8
ATTN_KV_HEADS = 2
ATTN_HEAD_DIM = 64
ATTN_WIDTH = ATTN_HEADS * ATTN_HEAD_DIM
ATTN_KV_WIDTH = ATTN_KV_HEADS * ATTN_HEAD_DIM
WINDOW = 128
BLOCK = 128
RET_HEADS = 4
RET_HEAD_DIM = 128
RET_WIDTH = RET_HEADS * RET_HEAD_DIM
RET_CHUNK = 128
MIX_WIDTH = ATTN_WIDTH + RET_WIDTH
IN_COLS = ATTN_WIDTH + 2 * ATTN_KV_WIDTH + 4 * RET_WIDTH
XA_HEADS = 4
XA_HEAD_DIM = D_MODEL // XA_HEADS
D_FF = -(-(8 * D_MODEL) // (3 * 256)) * 256
ROPE_THETA = 10000.0
EPS = 1e-6

kernel_name = "hybrid_swa_retention_memxattn_block"


def rms_norm(x, w):
    xf = x.astype(jnp.float32)
    y = xf * lax.rsqrt(jnp.mean(xf * xf, axis=-1, keepdims=True) + EPS)
    return (y * w.astype(jnp.float32)).astype(x.dtype)


def rope(x):
    S, d = x.shape[1], x.shape[-1]
    inv_freq = ROPE_THETA ** (-jnp.arange(0, d, 2, dtype=jnp.float32) / d)
    ang = jnp.arange(S, dtype=jnp.float32)[:, None] * inv_freq[None, :]
    cos = jnp.cos(ang)[None, :, None, :]
    sin = jnp.sin(ang)[None, :, None, :]
    xf = x.astype(jnp.float32)
    x1, x2 = xf[..., : d // 2], xf[..., d // 2:]
    return jnp.concatenate([x1 * cos - x2 * sin, x1 * sin + x2 * cos], axis=-1).astype(x.dtype)


def window_attention(q, k, v, sink):
    B, S = q.shape[0], q.shape[1]
    nb = S // BLOCK
    G = ATTN_HEADS // ATTN_KV_HEADS
    qb = q.reshape(B, nb, BLOCK, ATTN_KV_HEADS, G, ATTN_HEAD_DIM)
    pad = ((0, 0), (BLOCK, BLOCK), (0, 0), (0, 0))
    kp = jnp.pad(k, pad).reshape(B, nb + 2, BLOCK, ATTN_KV_HEADS, ATTN_HEAD_DIM)
    vp = jnp.pad(v, pad).reshape(B, nb + 2, BLOCK, ATTN_KV_HEADS, ATTN_HEAD_DIM)
    kw = jnp.concatenate([kp[:, :-2], kp[:, 1:-1], kp[:, 2:]], axis=2)
    vw = jnp.concatenate([vp[:, :-2], vp[:, 1:-1], vp[:, 2:]], axis=2)
    s = jnp.einsum('bnqhgd,bnkhd->bhgnqk', qb, kw).astype(jnp.float32) * (ATTN_HEAD_DIM ** -0.5)
    blk = jnp.arange(nb)[:, None, None]
    qpos = blk * BLOCK + jnp.arange(BLOCK)[None, :, None]
    kpos = (blk - 1) * BLOCK + jnp.arange(3 * BLOCK)[None, None, :]
    valid = (jnp.abs(qpos - kpos) <= WINDOW) & (kpos >= 0) & (kpos < S)
    s = jnp.where(valid, s, -jnp.inf)
    sk = sink.astype(jnp.float32).reshape(ATTN_KV_HEADS, G)[None, :, :, None, None, None]
    m = jnp.maximum(jnp.max(s, axis=-1, keepdims=True), sk)
    p = jnp.exp(s - m)
    p = p / (jnp.sum(p, axis=-1, keepdims=True) + jnp.exp(sk - m))
    o = jnp.einsum('bhgnqk,bnkhd->bnqhgd', p.astype(v.dtype), vw)
    return o.reshape(B, S, ATTN_WIDTH)


def retention_scan(q, k, v, log_gamma, strict):
    C = q.shape[3]
    idx = jnp.arange(C, dtype=jnp.float32)
    diff = idx[:, None] - idx[None, :]
    mask = (diff > 0) if strict else (diff >= 0)
    lg = log_gamma[:, None, None]
    dmask = jnp.where(mask[None], jnp.exp(jnp.where(mask[None], diff[None], 0.0) * lg), 0.0)
    s = jnp.einsum('bhncd,bhnmd->bhncm', q, k) * dmask[None, :, None].astype(q.dtype)
    intra = jnp.einsum('bhncm,bhnme->bhnce', s, v)
    k_dec = k * jnp.exp((C - 1 - idx)[None, :] * log_gamma[:, None])[None, :, None, :, None].astype(k.dtype)
    kv = jnp.einsum('bhncd,bhnce->nbhde', k_dec, v)
    chunk_decay = jnp.exp(C * log_gamma).astype(kv.dtype)[None, :, None, None]

    def step(state, kv_n):
        return state * chunk_decay + kv_n, state

    _, prev = lax.scan(step, jnp.zeros_like(kv[0]), kv)
    q_dec = q * jnp.exp((idx + 1)[None, :] * log_gamma[:, None])[None, :, None, :, None].astype(q.dtype)
    inter = jnp.einsum('bhncd,nbhde->bhnce', q_dec, prev)
    return intra + inter


def retention(q, k, v, g, decay_fwd, decay_bwd, gn_w):
    B, S = q.shape[0], q.shape[1]
    N = S // RET_CHUNK
    q = rope(q)
    k = rope(k) * (RET_HEAD_DIM ** -0.5)

    def chunk(t):
        return t.transpose(0, 2, 1, 3).reshape(B, RET_HEADS, N, RET_CHUNK, RET_HEAD_DIM)

    lg_f = jax.nn.log_sigmoid(decay_fwd.astype(jnp.float32))
    lg_b = jax.nn.log_sigmoid(decay_bwd.astype(jnp.float32))
    y_f = retention_scan(chunk(q), chunk(k), chunk(v), lg_f, False).reshape(B, RET_HEADS, S, RET_HEAD_DIM)
    y_b = retention_scan(chunk(q[:, ::-1]), chunk(k[:, ::-1]), chunk(v[:, ::-1]), lg_b, True)
    y_b = y_b.reshape(B, RET_HEADS, S, RET_HEAD_DIM)[:, :, ::-1]
    y = (y_f + y_b).transpose(0, 2, 1, 3).astype(jnp.float32)
    mu = jnp.mean(y, axis=-1, keepdims=True)
    var = jnp.mean(jnp.square(y - mu), axis=-1, keepdims=True)
    yn = ((y - mu) * lax.rsqrt(var + EPS)).reshape(B, S, RET_WIDTH) * gn_w.astype(jnp.float32)
    return (jax.nn.silu(g.astype(jnp.float32)) * yn).astype(g.dtype)


def setup_inputs(seed: int = 0) -> dict:
    key = jax.random.key(seed)
    ks = jax.random.split(key, 24)
    f32 = jnp.float32

    def w(k, shape, fan_in):
        return jax.random.normal(k, shape, f32) * (fan_in ** -0.5)

    def gain(k, n):
        return 1.0 + 0.05 * jax.random.normal(k, (DEPTH, n), f32)

    base = 1.0 - jnp.exp2(-5.0 - jnp.arange(RET_HEADS, dtype=f32))
    base_logit = jnp.log(base / (1.0 - base))
    return {
        "x": jax.random.normal(ks[0], (BATCH, SEQ, D_MODEL), f32),
        "mem": jax.random.normal(ks[1], (BATCH, N_MEM, D_MODEL), f32),
        "norm_mix_pre": gain(ks[2], D_MODEL),
        "norm_mix_post": gain(ks[3], D_MODEL),
        "w_in": w(ks[4], (DEPTH, D_MODEL, IN_COLS), D_MODEL),
        "attn_sink": 0.5 * jax.random.normal(ks[5], (DEPTH, ATTN_HEADS), f32),
        "attn_out_norm": gain(ks[6], ATTN_WIDTH),
        "ret_decay_fwd": base_logit[None] + 0.1 * jax.random.normal(ks[7], (DEPTH, RET_HEADS), f32),
        "ret_decay_bwd": base_logit[None] + 0.1 * jax.random.normal(ks[8], (DEPTH, RET_HEADS), f32),
        "ret_gn": gain(ks[9], RET_WIDTH),
        "w_out": w(ks[10], (DEPTH, MIX_WIDTH, D_MODEL), MIX_WIDTH),
        "norm_xa_pre": gain(ks[11], D_MODEL),
        "norm_xa_post": gain(ks[12], D_MODEL),
        "norm_mem": gain(ks[13], D_MODEL),
        "xa_wq": w(ks[14], (DEPTH, D_MODEL, D_MODEL), D_MODEL),
        "xa_wkv": w(ks[15], (DEPTH, D_MODEL, 2 * D_MODEL), D_MODEL),
        "xa_wo": w(ks[16], (DEPTH, D_MODEL, D_MODEL), D_MODEL),
        "norm_ffn_pre": gain(ks[17], D_MODEL),
        "norm_ffn_post": gain(ks[18], D_MODEL),
        "ffn_w_gu": w(ks[19], (DEPTH, D_MODEL, 2 * D_FF), D_MODEL),
        "ffn_w_down": w(ks[20], (DEPTH, D_FF, D_MODEL), D_FF),
    }


def reference(x, mem, norm_mix_pre, norm_mix_post, w_in, attn_sink, attn_out_norm,
              ret_decay_fwd, ret_decay_bwd, ret_gn, w_out, norm_xa_pre, norm_xa_post,
              norm_mem, xa_wq, xa_wkv, xa_wo, norm_ffn_pre, norm_ffn_post,
              ffn_w_gu, ffn_w_down):
    B, S, _ = x.shape
    M = mem.shape[1]
    o_k = ATTN_WIDTH
    o_v = o_k + ATTN_KV_WIDTH
    o_r = o_v + ATTN_KV_WIDTH
    for l in range(DEPTH):
        h = rms_norm(x, norm_mix_pre[l])
        z = h @ w_in[l]
        aq = z[..., :o_k].reshape(B, S, ATTN_HEADS, ATTN_HEAD_DIM)
        ak = z[..., o_k:o_v].reshape(B, S, ATTN_KV_HEADS, ATTN_HEAD_DIM)
        av = z[..., o_v:o_r].reshape(B, S, ATTN_KV_HEADS, ATTN_HEAD_DIM)
        rq, rk, rv, rg = jnp.split(z[..., o_r:], 4, axis=-1)
        a = window_attention(rope(aq), rope(ak), av, attn_sink[l])
        a = rms_norm(a, attn_out_norm[l])
        r = retention(rq.reshape(B, S, RET_HEADS, RET_HEAD_DIM),
                      rk.reshape(B, S, RET_HEADS, RET_HEAD_DIM),
                      rv.reshape(B, S, RET_HEADS, RET_HEAD_DIM),
                      rg, ret_decay_fwd[l], ret_decay_bwd[l], ret_gn[l])
        mix = jnp.concatenate([a, r], axis=-1) @ w_out[l]
        x = x + rms_norm(mix, norm_mix_post[l])

        h = rms_norm(x, norm_xa_pre[l])
        mn = rms_norm(mem, norm_mem[l])
        q = (h @ xa_wq[l]).reshape(B, S, XA_HEADS, XA_HEAD_DIM)
        kv = (mn @ xa_wkv[l]).reshape(B, M, 2, XA_HEADS, XA_HEAD_DIM)
        s = jnp.einsum('bshd,bmhd->bhsm', q, kv[:, :, 0]).astype(jnp.float32) * (XA_HEAD_DIM ** -0.5)
        p = jax.nn.softmax(s, axis=-1).astype(x.dtype)
        xo = jnp.einsum('bhsm,bmhd->bshd', p, kv[:, :, 1]).reshape(B, S, D_MODEL) @ xa_wo[l]
        x = x + rms_norm(xo, norm_xa_post[l])

        h = rms_norm(x, norm_ffn_pre[l])
        gate, up = jnp.split(h @ ffn_w_gu[l], 2, axis=-1)
        f = (jax.nn.silu(gate) * up) @ ffn_w_down[l]
        x = x + rms_norm(f, norm_ffn_post[l])
    return x
```

```cpp
#include <hip/hip_runtime.h>
#include <hip/hip_cooperative_groups.h>
#include <cstdio>
#include <cstdint>
#include <cmath>
namespace cg = cooperative_groups;
namespace pg8 {
#define PG8_LAS __attribute__((address_space(3)))
typedef unsigned short bf16_t;
typedef short bf16x8 __attribute__((ext_vector_type(8)));
typedef float f32x4 __attribute__((ext_vector_type(4)));
typedef unsigned u32x4 __attribute__((ext_vector_type(4)));
constexpr int BM = 256, BK = 64, HALF = 128, HTB = HALF * BK * 2  , STAGE_BYTES = 8 * HTB, NXCD = 8, WGM = 4;

__host__ __device__ __forceinline__ int lds_byte(int r, int c) { const int st = (r >> 4) * 2 + (c >> 5), rr = r & 15, cc = c & 31, ob = rr * 64 + cc * 2; return st * 1024 + (ob ^ (((ob >> 9) & 1) << 5)); }
__host__ __device__ __forceinline__ void stage_rc(int b, int& R, int& C) { const int st = b / 1024, sb = b % 1024, swz = sb ^ (((sb >> 9) & 1) << 5); R = (st >> 1) * 16 + swz / 64; C = (st & 1) * 32 + (swz % 64) / 2; }
__host__ __device__ __forceinline__ int perm32(int rho) { const int n = rho >> 4, i = rho & 15; return 8 * (i >> 2) + 4 * n + (i & 3); }

struct Unit { int pm, pn; };
struct Gemm { const bf16_t* A; const bf16_t* Bt; int M, N, K; int lda, ldb; int ppb; size_t bstrideB; };

struct StaticOrder {
    int nM, nN, nwg, G, c;
    __host__ __device__ void init(int M, int N, int G_, int c_) { nM = M / BM; nN = N / BM; nwg = nM * nN; G = G_; c = c_; }
    __host__ __device__ bool next(int i, Unit& u) const {
        const long L = (long)i * G + c; if (L >= nwg) return false;
        int wgid = (int)L; { const int q = nwg / NXCD, r = nwg % NXCD, xcd = wgid % NXCD, off = wgid / NXCD; wgid = (xcd < r ? xcd * (q + 1) : r * (q + 1) + (xcd - r) * q) + off; }
        const int nig = WGM * nN, gid = wgid / nig, fm = gid * WGM, gsz = (nM - fm) < WGM ? (nM - fm) : WGM;
        u.pm = fm + ((wgid % nig) % gsz); u.pn = (wgid % nig) / gsz; return true;
    }
    __device__ __forceinline__ void a_ready(const Unit&) const {}
    __device__ __forceinline__ void done(const Unit&) const {}
};

typedef __bf16 bf16v2 __attribute__((ext_vector_type(2)));
__device__ __forceinline__ unsigned cvt_pk_bf16(float lo, float hi) { bf16v2 v = {(__bf16)lo, (__bf16)hi}; return __builtin_bit_cast(unsigned, v); }
struct EpiBf16 {
    static constexpr bool PERM = true, AFTER_DRAIN = false;
    bf16_t* O; int ldc; float sc; const float* rs; const float* cs;
    __device__ __forceinline__ void operator()(const f32x4 (&acc)[2][2][4][2], const Unit& u, int wr, int wc, int fr, int fq) const {
        const int row0 = u.pm * BM + wr * 64 + fr; const int col0 = u.pn * BM + wc * 64 + 8 * fq;
        f32x4 c0[2], c1[2];
#pragma unroll
        for (int bj = 0; bj < 2; ++bj) { c0[bj] = (f32x4){sc, sc, sc, sc}; c1[bj] = c0[bj];
            if (cs) { c0[bj] = c0[bj] * *(const f32x4*)(cs + col0 + bj * 32); c1[bj] = c1[bj] * *(const f32x4*)(cs + col0 + bj * 32 + 4); } }
#pragma unroll
        for (int ai = 0; ai < 2; ++ai)
#pragma unroll
            for (int m = 0; m < 4; ++m) { bf16_t* rowp = O + (size_t)(row0 + ai * HALF + m * 16) * ldc + col0; const float rr = rs ? rs[row0 + ai * HALF + m * 16] : 1.0f;
#pragma unroll
                for (int bj = 0; bj < 2; ++bj) { f32x4 v0 = acc[ai][bj][m][0] * (c0[bj] * rr), v1 = acc[ai][bj][m][1] * (c1[bj] * rr);
                    u32x4 w; w.x = cvt_pk_bf16(v0[0], v0[1]); w.y = cvt_pk_bf16(v0[2], v0[3]); w.z = cvt_pk_bf16(v1[0], v1[1]); w.w = cvt_pk_bf16(v1[2], v1[3]);
                    *(u32x4*)(rowp + bj * 32) = w; } }
    }
};
struct EpiSoftmax {
    static constexpr bool PERM = true, AFTER_DRAIN = false;
    bf16_t* O; int ldc; const float* rs; PG8_LAS unsigned char* scr;
    __device__ __forceinline__ void operator()(f32x4 (&acc)[2][2][4][2], const Unit& u, int wr, int wc, int fr, int fq) const {
        const int row0 = u.pm * BM + wr * 64 + fr; const int col0 = u.pn * BM + wc * 64 + 8 * fq;
        PG8_LAS float* PM = (PG8_LAS float*)scr; PG8_LAS float* PS = PM + 1024;
#pragma unroll
        for (int ai = 0; ai < 2; ++ai)
#pragma unroll
            for (int m = 0; m < 4; ++m) { const int rl = ai * HALF + wr * 64 + m * 16 + fr; const float rr = rs[u.pm * BM + rl]; float mx = -INFINITY;
#pragma unroll
                for (int bj = 0; bj < 2; ++bj)
#pragma unroll
                    for (int n = 0; n < 2; ++n) { const f32x4 v = acc[ai][bj][m][n] * rr; acc[ai][bj][m][n] = v; mx = fmaxf(mx, fmaxf(fmaxf(v[0], v[1]), fmaxf(v[2], v[3]))); }
                mx = fmaxf(mx, __shfl_xor(mx, 16)); mx = fmaxf(mx, __shfl_xor(mx, 32));
                if (fq == 0) PM[rl * 4 + wc] = mx; }
        asm volatile("s_waitcnt lgkmcnt(0)" ::: "memory"); __builtin_amdgcn_s_barrier(); asm volatile("" ::: "memory");
#pragma unroll
        for (int ai = 0; ai < 2; ++ai)
#pragma unroll
            for (int m = 0; m < 4; ++m) { const int rl = ai * HALF + wr * 64 + m * 16 + fr; const f32x4 m4 = *(const PG8_LAS f32x4*)(PM + rl * 4);
                const float mrow = fmaxf(fmaxf(m4[0], m4[1]), fmaxf(m4[2], m4[3])); float sm = 0.f;
#pragma unroll
                for (int bj = 0; bj < 2; ++bj)
#pragma unroll
                    for (int n = 0; n < 2; ++n) { f32x4 v = acc[ai][bj][m][n];
                        v[0] = __builtin_amdgcn_exp2f(v[0] - mrow); v[1] = __builtin_amdgcn_exp2f(v[1] - mrow); v[2] = __builtin_amdgcn_exp2f(v[2] - mrow); v[3] = __builtin_amdgcn_exp2f(v[3] - mrow);
                        acc[ai][bj][m][n] = v; sm += (v[0] + v[1]) + (v[2] + v[3]); }
                sm += __shfl_xor(sm, 16); sm += __shfl_xor(sm, 32);
                if (fq == 0) PS[rl * 4 + wc] = sm; }
        asm volatile("s_waitcnt lgkmcnt(0)" ::: "memory"); __builtin_amdgcn_s_barrier(); asm volatile("" ::: "memory");
#pragma unroll
        for (int ai = 0; ai < 2; ++ai)
#pragma unroll
            for (int m = 0; m < 4; ++m) { const int rl = ai * HALF + wr * 64 + m * 16 + fr; const f32x4 s4 = *(const PG8_LAS f32x4*)(PS + rl * 4);
                const float inv = 1.0f / ((s4[0] + s4[1]) + (s4[2] + s4[3])); bf16_t* rowp = O + (size_t)(u.pm * BM + rl) * ldc + col0;
#pragma unroll
                for (int bj = 0; bj < 2; ++bj) { const f32x4 v0 = acc[ai][bj][m][0] * inv, v1 = acc[ai][bj][m][1] * inv;
                    u32x4 w; w.x = cvt_pk_bf16(v0[0], v0[1]); w.y = cvt_pk_bf16(v0[2], v0[3]); w.z = cvt_pk_bf16(v1[0], v1[1]); w.w = cvt_pk_bf16(v1[2], v1[3]);
                    *(u32x4*)(rowp + bj * 32) = w; } }
        (void)row0;
    }
};
__device__ __forceinline__ float silu_f(float x) { return x * __builtin_amdgcn_rcpf(1.0f + __builtin_amdgcn_exp2f(-1.44269504089f * x)); }
struct EpiSwiglu {
    static constexpr bool PERM = true, AFTER_DRAIN = false;
    bf16_t* O; int ldc; const float* rs;
    __device__ __forceinline__ void operator()(const f32x4 (&acc)[2][2][4][2], const Unit& u, int wr, int wc, int fr, int fq) const {
        const int row0 = u.pm * BM + wr * 64 + fr; const int col0 = u.pn * HALF + wc * 32 + 8 * fq;
#pragma unroll
        for (int ai = 0; ai < 2; ++ai)
#pragma unroll
            for (int m = 0; m < 4; ++m) { bf16_t* rowp = O + (size_t)(row0 + ai * HALF + m * 16) * ldc + col0;
                const float rr = rs[row0 + ai * HALF + m * 16];
                const f32x4 g0 = acc[ai][0][m][0] * rr, g1 = acc[ai][0][m][1] * rr, u0 = acc[ai][1][m][0] * rr, u1 = acc[ai][1][m][1] * rr;
                u32x4 w;
                w.x = cvt_pk_bf16(silu_f(g0[0]) * u0[0], silu_f(g0[1]) * u0[1]); w.y = cvt_pk_bf16(silu_f(g0[2]) * u0[2], silu_f(g0[3]) * u0[3]);
                w.z = cvt_pk_bf16(silu_f(g1[0]) * u1[0], silu_f(g1[1]) * u1[1]); w.w = cvt_pk_bf16(silu_f(g1[2]) * u1[2], silu_f(g1[3]) * u1[3]);
                *(u32x4*)rowp = w; }
    }
};

template <class Epi, class Sched, bool ALIGN_EPI = false, bool SP2 = false>
__device__ __forceinline__ void gemm_phase(PG8_LAS unsigned char* lds, const Gemm g, const Sched& S, const Epi& E) {
    const int tid = threadIdx.x, wid = __builtin_amdgcn_readfirstlane(tid >> 6), lane = tid & 63, wr = wid >> 2, wc = wid & 3, fr = lane & 15, fq = lane >> 4;
    const int K = g.K, nt = K / BK;
    unsigned voffA[2], voffB[2], voffB1[2];
#pragma unroll
    for (int i = 0; i < 2; ++i) { int R, C; stage_rc(tid * 16 + i * 8192, R, C); const int Rb = Epi::PERM ? (64 * (R >> 5) + perm32(R & 31)) : R, Rb1 = Epi::PERM ? Rb + 32 : R + HALF;
        voffA[i] = (unsigned)(R * g.lda + C) * 2u; voffB[i] = (unsigned)(Rb * g.ldb + C) * 2u; voffB1[i] = (unsigned)(Rb1 * g.ldb + C) * 2u; }
    const size_t kstep = (size_t)(BK * 2);
    const size_t hstepA = (size_t)HALF * g.lda * 2, hstepB = (size_t)HALF * g.ldb * 2;
    const size_t tstepA = 2 * hstepA, tstepB = 2 * hstepB;
#define PG8_BOFF(u) ((g.ppb ? (size_t)((u).pm / g.ppb) * g.bstrideB * 2 : (size_t)0) + (size_t)(u).pn * tstepB)
    const unsigned ldsw = (unsigned)wid * 1024u;
    const int aoff = lds_byte(wr * 64 + fr, fq * 8), boff = lds_byte(wc * 32 + fr, fq * 8);
#define PG8_SA(b, h) (((b) * 2 + (h)) * HTB)
#define PG8_SB(b, h) ((4 + (b) * 2 + (h)) * HTB)
#define PG8_STAGE(bufoff, gbase, voff) do { _Pragma("unroll") for (int _i = 0; _i < 2; ++_i) \
        __builtin_amdgcn_global_load_lds((const unsigned*)((const char*)(gbase) + (voff)[_i]), (PG8_LAS unsigned*)(lds + (bufoff) + ldsw + _i * 8192), 16, 0, 0); } while (0)
#define PG8_LDA(dst, b, h) do { _Pragma("unroll") for (int m = 0; m < 4; ++m) _Pragma("unroll") for (int k = 0; k < 2; ++k) dst[m][k] = *(const PG8_LAS bf16x8*)(lds + PG8_SA(b, h) + aoff + m * 2048 + k * 1024); } while (0)
#define PG8_LDB(dst, b, h) do { _Pragma("unroll") for (int n = 0; n < 2; ++n) _Pragma("unroll") for (int k = 0; k < 2; ++k) dst[n][k] = *(const PG8_LAS bf16x8*)(lds + PG8_SB(b, h) + boff + n * 2048 + k * 1024); } while (0)
#define PG8_MMA(ai, bj, At, Bt) do { __builtin_amdgcn_s_setprio(1); _Pragma("unroll") for (int m = 0; m < 4; ++m) _Pragma("unroll") for (int n = 0; n < 2; ++n) _Pragma("unroll") for (int k = 0; k < 2; ++k) \
        acc[ai][bj][m][n] = __builtin_amdgcn_mfma_f32_16x16x32_bf16(Bt[n][k], At[m][k], acc[ai][bj][m][n], 0, 0, 0); __builtin_amdgcn_s_setprio(0); } while (0)
#define PG8_WAIT_V(n) asm volatile("s_waitcnt vmcnt(" #n ")" ::: "memory")
#define PG8_WAIT_L(n) asm volatile("s_waitcnt lgkmcnt(" #n ")" ::: "memory")
#define PG8_BAR __builtin_amdgcn_s_barrier()
#define PG8_SCHED __builtin_amdgcn_sched_barrier(0)
    Unit cur, nxt; int ui = 0;
    if (!S.next(0, cur)) return;
    f32x4 acc[2][2][4][2];
#pragma unroll
    for (int a = 0; a < 2; ++a)
#pragma unroll
        for (int b = 0; b < 2; ++b)
#pragma unroll
            for (int m = 0; m < 4; ++m)
#pragma unroll
                for (int n = 0; n < 2; ++n) acc[a][b][m][n] = (f32x4){0.f, 0.f, 0.f, 0.f};
    bf16x8 At[4][2], B0[2][2], B1[2][2];
    const char* cA = (const char*)g.A + (size_t)cur.pm * tstepA; const char* cB = (const char*)g.Bt + PG8_BOFF(cur);
    S.a_ready(cur);
    if constexpr (SP2) {
        PG8_STAGE(PG8_SB(0, 0), cB, voffB); PG8_STAGE(PG8_SB(0, 1), cB, voffB1); PG8_STAGE(PG8_SA(0, 0), cA, voffA); PG8_STAGE(PG8_SA(0, 1), cA + hstepA, voffA);
        if (wr == 1) PG8_BAR;
        PG8_WAIT_V(2); PG8_BAR;
        PG8_STAGE(PG8_SB(1, 0), cB + kstep, voffB); PG8_STAGE(PG8_SA(1, 0), cA + kstep, voffA); PG8_STAGE(PG8_SB(1, 1), cB + kstep, voffB1);
        PG8_WAIT_V(6); PG8_BAR;
    } else {
        PG8_STAGE(PG8_SB(0, 0), cB, voffB); PG8_STAGE(PG8_SA(0, 0), cA, voffA); PG8_STAGE(PG8_SB(0, 1), cB, voffB1); PG8_STAGE(PG8_SA(0, 1), cA + hstepA, voffA);
        if (wr == 1) PG8_BAR;
        PG8_WAIT_V(4); PG8_BAR;
        PG8_STAGE(PG8_SB(1, 0), cB + kstep, voffB); PG8_STAGE(PG8_SA(1, 0), cA + kstep, voffA); PG8_STAGE(PG8_SB(1, 1), cB + kstep, voffB1);
        PG8_WAIT_V(6); PG8_BAR;
    }
    for (;;) {
        const bool has_next = S.next(ui + 1, nxt);
        const char* nA = has_next ? (const char*)g.A + (size_t)nxt.pm * tstepA : cA; const char* nB = has_next ? (const char*)g.Bt + PG8_BOFF(nxt) : cB;
        for (int t = 0; t < nt; t += 2) {
            const bool last = (t == nt - 2);
            const char* a1 = cA + (size_t)(t + 1) * kstep;
            const char* a2 = last ? nA : cA + (size_t)(t + 2) * kstep; const char* b2 = last ? nB : cB + (size_t)(t + 2) * kstep;
            const char* a3 = a2 + kstep; const char* b3 = b2 + kstep;
            if (last && has_next) S.a_ready(nxt);
            if constexpr (SP2) {
            PG8_LDB(B0, 0, 0); PG8_LDB(B1, 0, 1); PG8_SCHED; PG8_LDA(At, 0, 0); PG8_STAGE(PG8_SA(1, 1), a1 + hstepA, voffA);
            PG8_WAIT_V(8); PG8_WAIT_L(0); PG8_BAR; PG8_MMA(0, 0, At, B0); PG8_MMA(0, 1, At, B1); PG8_BAR; PG8_SCHED;
            PG8_LDA(At, 0, 1); PG8_STAGE(PG8_SB(0, 0), b2, voffB); PG8_STAGE(PG8_SB(0, 1), b2, voffB1); PG8_STAGE(PG8_SA(0, 0), a2, voffA);
            PG8_WAIT_V(8); PG8_WAIT_L(0); PG8_BAR; PG8_MMA(1, 0, At, B0); PG8_MMA(1, 1, At, B1); PG8_BAR; PG8_SCHED;
            PG8_LDB(B0, 1, 0); PG8_LDB(B1, 1, 1); PG8_SCHED; PG8_LDA(At, 1, 0); PG8_STAGE(PG8_SA(0, 1), a2 + hstepA, voffA);
            PG8_WAIT_V(8); PG8_WAIT_L(0); PG8_BAR; PG8_MMA(0, 0, At, B0); PG8_MMA(0, 1, At, B1); PG8_BAR; PG8_SCHED;
            PG8_LDA(At, 1, 1); PG8_STAGE(PG8_SB(1, 0), b3, voffB); PG8_STAGE(PG8_SB(1, 1), b3, voffB1); PG8_STAGE(PG8_SA(1, 0), a3, voffA);
            PG8_WAIT_V(8); PG8_WAIT_L(0); PG8_BAR; PG8_MMA(1, 0, At, B0); PG8_MMA(1, 1, At, B1); PG8_BAR; PG8_SCHED;
            } else {
            PG8_LDB(B0, 0, 0); PG8_SCHED; PG8_LDA(At, 0, 0); PG8_STAGE(PG8_SA(1, 1), a1 + hstepA, voffA);
            PG8_WAIT_L(8); PG8_BAR; PG8_WAIT_L(0); PG8_MMA(0, 0, At, B0); PG8_BAR; PG8_SCHED;
            PG8_LDB(B1, 0, 1); PG8_STAGE(PG8_SB(0, 0), b2, voffB);
            PG8_BAR; PG8_WAIT_L(0); PG8_MMA(0, 1, At, B1); PG8_BAR;
            PG8_LDA(At, 0, 1); PG8_STAGE(PG8_SA(0, 0), a2, voffA);
            PG8_BAR; PG8_WAIT_L(0); PG8_MMA(1, 0, At, B0); PG8_BAR; PG8_SCHED;
            PG8_STAGE(PG8_SB(0, 1), b2, voffB1);
            PG8_WAIT_V(6); PG8_BAR; PG8_MMA(1, 1, At, B1); PG8_BAR;
            PG8_LDB(B0, 1, 0); PG8_SCHED; PG8_LDA(At, 1, 0); PG8_STAGE(PG8_SA(0, 1), a2 + hstepA, voffA);
            PG8_WAIT_L(8); PG8_BAR; PG8_WAIT_L(0); PG8_MMA(0, 0, At, B0); PG8_BAR; PG8_SCHED;
            PG8_LDB(B1, 1, 1); PG8_STAGE(PG8_SB(1, 0), b3, voffB);
            PG8_BAR; PG8_WAIT_L(0); PG8_MMA(0, 1, At, B1); PG8_BAR;
            PG8_LDA(At, 1, 1); PG8_STAGE(PG8_SA(1, 0), a3, voffA);
            PG8_BAR; PG8_WAIT_L(0); PG8_MMA(1, 0, At, B0); PG8_BAR; PG8_SCHED;
            PG8_STAGE(PG8_SB(1, 1), b3, voffB1);
            PG8_WAIT_V(6); PG8_BAR; PG8_MMA(1, 1, At, B1); PG8_BAR;
            }
        }
        if constexpr (ALIGN_EPI) { if (wr == 0) PG8_BAR; }
        if constexpr (!Epi::AFTER_DRAIN) { E(acc, cur, wr, wc, fr, fq); S.done(cur); }
        if (!has_next) break;
#pragma unroll
        for (int a = 0; a < 2; ++a)
#pragma unroll
            for (int b = 0; b < 2; ++b)
#pragma unroll
                for (int m = 0; m < 4; ++m)
#pragma unroll
                    for (int n = 0; n < 2; ++n) acc[a][b][m][n] = (f32x4){0.f, 0.f, 0.f, 0.f};
        cur = nxt; cA = nA; cB = nB; ++ui;
        if constexpr (ALIGN_EPI) { if (wr == 1) PG8_BAR; }
    }
    PG8_WAIT_V(0);
    if constexpr (!ALIGN_EPI) { if (wr == 0) PG8_BAR; }
    PG8_BAR;
    if constexpr (Epi::AFTER_DRAIN) { E.fused(acc, cur, wr, wc, fr, fq, lds, wid, lane); S.done(cur); }
#undef PG8_BOFF
#undef PG8_SA
#undef PG8_SB
#undef PG8_STAGE
#undef PG8_LDA
#undef PG8_LDB
#undef PG8_MMA
#undef PG8_WAIT_V
#undef PG8_WAIT_L
#undef PG8_BAR
#undef PG8_SCHED
}
}

namespace mk {
#define LAS __attribute__((address_space(3)))
#define DI __device__ __forceinline__
typedef unsigned short bf16_t;
typedef short bf16x8 __attribute__((ext_vector_type(8)));
typedef short bf16x4 __attribute__((ext_vector_type(4)));
typedef float f32x4 __attribute__((ext_vector_type(4)));
typedef float f32x2 __attribute__((ext_vector_type(2)));
typedef unsigned u32x4 __attribute__((ext_vector_type(4)));
typedef unsigned u32x2 __attribute__((ext_vector_type(2)));
typedef LAS unsigned char* ldsp;
#define MFMA16(a, b, c) __builtin_amdgcn_mfma_f32_16x16x32_bf16((a), (b), (c), 0, 0, 0)

constexpr int NB = 4, S = 8192, T = NB * S, D = 1024, INC = 2816, FF = 2816, NMEM = 256, MT = NB * NMEM;
constexpr int ZLD = 2304, ZQ = 0, ZK = 512, ZV = 640, ZRQ = 768, ZRK = 1280, ZRG = 1792;
constexpr float EPS = 1e-6f, LOG2E = 1.44269504089f;
constexpr size_t MiB = 1u << 20;
constexpr size_t WS_WIN = 1 * MiB, WS_WOUT = 7 * MiB, WS_WQ = 9 * MiB, WS_WKV = 11 * MiB, WS_WO = 15 * MiB, WS_WGU = 17 * MiB, WS_WDN = 28 * MiB;
constexpr size_t WS_ROPE64 = 34 * MiB, WS_ROPE128 = 36 * MiB, WS_MN = 40 * MiB, WS_KVM = 42 * MiB;
constexpr size_t WS_GT = 484 * MiB, WS_UT = 492 * MiB;
constexpr size_t WS_H = 48 * MiB, WS_Z = 112 * MiB, WS_VTR = 256 * MiB, WS_MIXCAT = 289 * MiB, WS_KVI = 354 * MiB, WS_PRV = 418 * MiB, WS_END = 500 * MiB;
constexpr int VTR_LD = T + 128, VTM_LD = MT + 128;
constexpr size_t WS_R0 = 33 * MiB + 512 * 1024, WS_R1 = WS_R0 + 131072, WS_R2 = WS_R1 + 131072;
constexpr size_t WS_ASQ = 47 * MiB;
constexpr size_t WS_XB = 418 * MiB;
constexpr size_t WS_MIXO = 112 * MiB, WS_Q = 176 * MiB, WS_AO = 289 * MiB, WS_XO = 112 * MiB, WS_F = 176 * MiB, WS_DN = 112 * MiB;
constexpr int LDS_BYTES = 147456;
constexpr int NPH = 14;
#ifndef REP_MASK
#define REP_MASK 0x0
#endif

struct Args { const float* in[21]; float* out; unsigned char* ws; int ph_lo, ph_hi; };

DI float bf2f(short v) { return __uint_as_float(((unsigned)(unsigned short)v) << 16); }
DI unsigned pk2(float lo, float hi) { return pg8::cvt_pk_bf16(lo, hi); }
DI float wave_sum(float v) {
#pragma unroll
    for (int o = 1; o < 64; o <<= 1) v += __shfl_xor(v, o);
    return v;
}
DI float ex2(float x) { return __builtin_amdgcn_exp2f(x); }

#define RLX_AGENT __ATOMIC_RELAXED, __HIP_MEMORY_SCOPE_AGENT
#define XB_TMO      128
#define XB_XCNT(j)  (256  + 64 * (j))
#define XB_XSUB(j)  (1280 + 64 * (j))
#define XB_XGEN(j)  (2304 + 64 * (j))
#define XB_TOP      3328
#define XB_TOPGEN   3392
#define XCD_BAR_WORDS 3456
#define XB_SPIN_CAP (1u << 18)

__device__ __forceinline__ unsigned xb_ld(unsigned* p)              { return __hip_atomic_load(p, __ATOMIC_RELAXED, __HIP_MEMORY_SCOPE_AGENT); }
__device__ __forceinline__ unsigned xb_add(unsigned* p, unsigned v) { return __hip_atomic_fetch_add(p, v, __ATOMIC_RELAXED, __HIP_MEMORY_SCOPE_AGENT); }
__device__ __forceinline__ unsigned xb_xcc_id() { return (unsigned)__builtin_amdgcn_s_getreg((3 << 11) | 20) & 0xFu; }
#define XB_SPIN(cond, bar) do { unsigned _sp = 0; while (cond) { __builtin_amdgcn_s_sleep(1); \
    if ((++_sp & 255u) == 0u) { if (xb_ld(&(bar)[XB_TMO])) break; if (_sp > XB_SPIN_CAP) { atomicAdd(&(bar)[XB_TMO], 1u); break; } } } } while (0)

struct XcdBarrier {
    unsigned* bar; unsigned x;
    volatile LAS unsigned* st;
};

__device__ __forceinline__ XcdBarrier xcd_barrier_post(unsigned* bar, volatile LAS unsigned* st) {
    XcdBarrier b; b.bar = bar; b.x = xb_xcc_id(); b.st = st;
    if (threadIdx.x == 0) (void)xb_add(&bar[XB_XCNT(b.x)], 1u);
    return b;
}
__device__ __forceinline__ void xcd_barrier_complete(unsigned* bar, unsigned x, unsigned& nloc, unsigned& nx) {
    const unsigned G = gridDim.x * gridDim.y * gridDim.z;
    unsigned sum, cnt, mine, sp = 0u;
    for (;;) {
        sum = 0u; cnt = 0u; mine = 0u;
#pragma unroll
        for (unsigned j = 0; j < 16; ++j) { const unsigned c = xb_ld(&bar[XB_XCNT(j)]); sum += c; cnt += (c > 0u) ? 1u : 0u; mine = (j == x) ? c : mine; }
        if (sum == G) break;
        __builtin_amdgcn_s_sleep(1);
        if ((++sp & 255u) == 0u) { if (xb_ld(&bar[XB_TMO])) break; if (sp > XB_SPIN_CAP) { atomicAdd(&bar[XB_TMO], 1u); break; } }
    }
    nloc = mine > 0u ? mine : 1u; nx = cnt > 0u ? cnt : 1u;
}

__device__ __forceinline__ void xcd_barrier(const XcdBarrier& b) {
    asm volatile("s_waitcnt vmcnt(0)" ::: "memory");
    __syncthreads();
    if (threadIdx.x == 0) {
        unsigned* bar = b.bar;
        __builtin_amdgcn_s_waitcnt(0);
        unsigned nloc = b.st[0], nx = b.st[1];
        if (nloc == 0u) { xcd_barrier_complete(bar, b.x, nloc, nx); b.st[0] = nloc; b.st[1] = nx; }
        const unsigned old = xb_add(&bar[XB_XSUB(b.x)], 1u);
        const unsigned gen = old / nloc;
        if (old + 1u == (gen + 1u) * nloc) {
            __builtin_amdgcn_fence(__ATOMIC_RELEASE, "agent");
            asm volatile("s_waitcnt vmcnt(0)" ::: "memory");
            const unsigned og = xb_add(&bar[XB_TOP], 1u);
            const unsigned tg = og / nx;
            if (og + 1u == (tg + 1u) * nx) xb_add(&bar[XB_TOPGEN], 1u);
            else XB_SPIN(xb_ld(&bar[XB_TOPGEN]) == tg, bar);
            __builtin_amdgcn_fence(__ATOMIC_ACQUIRE, "agent");
            xb_add(&bar[XB_XGEN(b.x)], 1u);
            asm volatile("s_waitcnt vmcnt(0)" ::: "memory");
        } else {
            XB_SPIN(xb_ld(&bar[XB_XGEN(b.x)]) == gen, bar);
            __builtin_amdgcn_fence(__ATOMIC_ACQUIRE, "agent");
            asm volatile("s_waitcnt vmcnt(0)" ::: "memory");
        }
    }
    __syncthreads();
}

DI void p0_transpose_item(const float* W, int K, int N, bf16_t* WT, int k0, int n0, int drow0, LAS float* scr, int lane, const float* wk) {
    float wv[32];
#pragma unroll
    for (int i = 0; i < 32; ++i) { const int kk = 2 * i + (lane >> 5); wv[i] = W[(size_t)(k0 + kk) * N + n0 + (lane & 31)]; }
    const float wk0 = wk ? wk[k0 + lane] : 1.0f;
#pragma unroll
    for (int i = 0; i < 32; ++i) { const int kk = 2 * i + (lane >> 5); scr[kk * 33 + (lane & 31)] = wv[i] * __shfl(wk0, kk); }
    asm volatile("s_waitcnt lgkmcnt(0)" ::: "memory");
    const int c = lane & 7;
#pragma unroll
    for (int j = 0; j < 4; ++j) { const int n = (lane >> 3) + 8 * j; const LAS float* s = scr + (8 * c) * 33 + n;
        u32x4 o; o.x = pk2(s[0 * 33], s[1 * 33]); o.y = pk2(s[2 * 33], s[3 * 33]); o.z = pk2(s[4 * 33], s[5 * 33]); o.w = pk2(s[6 * 33], s[7 * 33]);
        *(u32x4*)(WT + (size_t)(drow0 + n) * K + k0 + 8 * c) = o; }
    asm volatile("s_waitcnt lgkmcnt(0)" ::: "memory");
}
DI void p0_transpose(const float* W, int K, int N, bf16_t* WT, int item, bool gu, LAS float* scr, int lane, bool win = false, const float* wk = nullptr) {
    const int nblk = N / 32, kb = item / nblk, nb = item % nblk, n0 = 32 * nb;
    int dr = n0;
    if (win) { dr = n0 < 1792 ? n0 : (n0 < 2304 ? n0 + 512 : n0 - 512); }
    if (gu) { const int j = n0 < FF ? n0 : n0 - FF; dr = 256 * (j / 128) + 64 * ((j % 128) >> 5) + (n0 < FF ? 0 : 32); }
    p0_transpose_item(W, K, N, WT, 64 * kb, n0, dr, scr, lane, wk);
}
DI void rms_row_to_bf16(const float* xrow, const float* w, bf16_t* orow, int lane) {
    const f32x4* xr = (const f32x4*)xrow + lane; const f32x4* wr = (const f32x4*)w + lane;
    f32x4 v[4]; float s = 0.f;
#pragma unroll
    for (int j = 0; j < 4; ++j) { v[j] = xr[64 * j]; s += (v[j].x * v[j].x + v[j].y * v[j].y) + (v[j].z * v[j].z + v[j].w * v[j].w); }
    const float r = 1.0f / sqrtf(wave_sum(s) * (1.0f / D) + EPS);
    u32x2* o8 = (u32x2*)orow + lane;
#pragma unroll
    for (int j = 0; j < 4; ++j) { const f32x4 ww = wr[64 * j]; u32x2 o; o.x = pk2(v[j].x * r * ww.x, v[j].y * r * ww.y); o.y = pk2(v[j].z * r * ww.z, v[j].w * r * ww.w); o8[64 * j] = o; }
}
DI void p1_late_weights(const Args& a, ldsp lds, int gw, int NGW, int wave, int lane) {
    unsigned char* ws = a.ws; LAS float* scr = (LAS float*)(lds + wave * 16384);
    constexpr int I_SQ = 16 * 32, I_GU = 16 * 176, I_DN = 44 * 32;
    for (int it = gw; it < I_SQ + I_GU + I_DN; it += NGW) {
        int r = it;
        if (r < I_SQ) { p0_transpose(a.in[10], D, D, (bf16_t*)(ws + WS_WOUT), r, false, scr, lane); continue; } r -= I_SQ;
        if (r < I_GU) { p0_transpose(a.in[19], D, 2 * FF, (bf16_t*)(ws + WS_WGU), r, true, scr, lane, false, a.in[17]); continue; } r -= I_GU;
        p0_transpose(a.in[20], FF, D, (bf16_t*)(ws + WS_WDN), r, false, scr, lane);
    }
}
DI void row_copy_rs(const float* xrow, bf16_t* orow, float* rsp, int lane) {
    const f32x4* xr = (const f32x4*)xrow + lane; f32x4 v[4]; float s = 0.f;
#pragma unroll
    for (int j = 0; j < 4; ++j) { v[j] = xr[64 * j]; s += (v[j].x * v[j].x + v[j].y * v[j].y) + (v[j].z * v[j].z + v[j].w * v[j].w); }
    s = wave_sum(s);
    u32x2* o8 = (u32x2*)orow + lane;
#pragma unroll
    for (int j = 0; j < 4; ++j) { u32x2 o; o.x = pk2(v[j].x, v[j].y); o.y = pk2(v[j].z, v[j].w); o8[64 * j] = o; }
    if (lane == 0) *rsp = 1.0f / sqrtf(s * (1.0f / D) + EPS);
}
DI void p0_prologue(const Args& a, ldsp lds, int wave, int lane) {
    unsigned char* ws = a.ws;
    LAS float* scr = (LAS float*)(lds + wave * 16384);
    const int gw = blockIdx.x * 8 + wave, NGW = gridDim.x * 8;
    constexpr int I_IN = 16 * 88, I_SQ = 16 * 32, I_KV = 16 * 64;
    constexpr int NITEMS = I_IN + I_KV + I_SQ;
    for (int it = gw; it < NITEMS; it += NGW) {
        int r = it;
        if (r < I_IN) { p0_transpose(a.in[4], D, INC, (bf16_t*)(ws + WS_WIN), r, false, scr, lane, true, a.in[2]); continue; } r -= I_IN;
        if (r < I_KV) { p0_transpose(a.in[15], D, 2 * D, (bf16_t*)(ws + WS_WKV), r, false, scr, lane); continue; } r -= I_KV;
        p0_transpose(a.in[16], D, D, (bf16_t*)(ws + WS_WO), r, false, scr, lane);
    }
    {
        const int gt = blockIdx.x * 512 + threadIdx.x, NT = gridDim.x * 512;
        for (int e = gt; e < D * D / 4; e += NT) { const f32x4 v = ((const f32x4*)a.in[14])[e]; const float sc_ = a.in[11][e >> 8] * (0.0625f * LOG2E);
            u32x2 o; o.x = pk2(v.x * sc_, v.y * sc_); o.y = pk2(v.z * sc_, v.w * sc_); ((u32x2*)(ws + WS_WQ))[e] = o; }
    }
    {
        const int gt = blockIdx.x * 512 + threadIdx.x, NT = gridDim.x * 512;
        f32x2* r64 = (f32x2*)(ws + WS_ROPE64); f32x2* r128 = (f32x2*)(ws + WS_ROPE128);
        for (int e = gt; e < S * 96; e += NT) {
            const int s = e / 96, j = e % 96;
            const int i = j < 32 ? j : j - 32; const float dd = j < 32 ? 64.f : 128.f;
            const float inv_freq = powf(10000.0f, -(float)(2 * i) / dd);
            const float ang = (float)s * inv_freq;
            const double ad = (double)ang; const double nn = rint(ad * 0.15915494309189535); const float rr = (float)(ad - nn * 6.283185307179586);
            const f32x2 cs = {cosf(rr), sinf(rr)};
            if (j < 32) r64[s * 32 + i] = cs; else r128[s * 64 + i] = cs;
        }
    }
    for (int m = 2 * gw; m < T; m += 2 * NGW) {
        const f32x4* xr = (const f32x4*)(a.in[0] + (size_t)m * D) + lane; f32x4 v[8]; float s0 = 0.f, s1 = 0.f;
#pragma unroll
        for (int j = 0; j < 8; ++j) v[j] = __builtin_nontemporal_load(xr + 64 * j);
#pragma unroll
        for (int j = 0; j < 4; ++j) { s0 += (v[j].x * v[j].x + v[j].y * v[j].y) + (v[j].z * v[j].z + v[j].w * v[j].w); s1 += (v[4 + j].x * v[4 + j].x + v[4 + j].y * v[4 + j].y) + (v[4 + j].z * v[4 + j].z + v[4 + j].w * v[4 + j].w); }
        s0 = wave_sum(s0); s1 = wave_sum(s1);
        u32x2* o8 = (u32x2*)((bf16_t*)(ws + WS_H) + (size_t)m * D) + lane;
#pragma unroll
        for (int j = 0; j < 8; ++j) { u32x2 o; o.x = pk2(v[j].x, v[j].y); o.y = pk2(v[j].z, v[j].w); o8[64 * j] = o; }
        if (lane == 0) { float* rp = (float*)(ws + WS_R0) + m; rp[0] = 1.0f / sqrtf(s0 * (1.0f / D) + EPS); rp[1] = 1.0f / sqrtf(s1 * (1.0f / D) + EPS); }
    }
    for (int mm = gw; mm < MT; mm += NGW) rms_row_to_bf16(a.in[1] + (size_t)mm * D, a.in[13], (bf16_t*)(ws + WS_MN) + (size_t)mm * D, lane);
}

template <bool BASE_BF16, bool OUT_BF16, bool ASQ = false>
DI void rowwise_phase(const bf16_t* Y, const void* base, const float* wpost, void* outp, float* rnext, int wave, int lane, const float* asq = nullptr) {
    const int gw = blockIdx.x * 8 + wave, NGW = gridDim.x * 8;
    for (int row0 = 2 * gw; row0 < T; row0 += 2 * NGW) {
        f32x4 y[2][4], bv[2][4]; u32x2 yu[2][4], bu[2][4]; f32x4 q0[2], q1[2];
#pragma unroll
        for (int t = 0; t < 2; ++t) { const size_t row = (size_t)(row0 + t);
#pragma unroll
            for (int j = 0; j < 4; ++j) { yu[t][j] = __builtin_nontemporal_load((const u32x2*)(Y + row * D) + lane + 64 * j);
                if (BASE_BF16) bu[t][j] = ((const u32x2*)((const bf16_t*)base + row * D) + lane)[64 * j];
                else bv[t][j] = ((const f32x4*)((const float*)base + row * D) + lane)[64 * j]; }
            if (ASQ) { q0[t] = *(const f32x4*)(asq + row * 8); q1[t] = *(const f32x4*)(asq + row * 8 + 4); } }
#pragma unroll
        for (int t = 0; t < 2; ++t) { const size_t row = (size_t)(row0 + t); float ss = 0.f;
#pragma unroll
            for (int j = 0; j < 4; ++j) { const u32x2 u = yu[t][j];
                if (BASE_BF16) { const u32x2 q = bu[t][j]; bv[t][j].x = __uint_as_float(q.x << 16); bv[t][j].y = __uint_as_float(q.x & 0xffff0000u); bv[t][j].z = __uint_as_float(q.y << 16); bv[t][j].w = __uint_as_float(q.y & 0xffff0000u); }
                y[t][j].x = __uint_as_float(u.x << 16); y[t][j].y = __uint_as_float(u.x & 0xffff0000u); y[t][j].z = __uint_as_float(u.y << 16); y[t][j].w = __uint_as_float(u.y & 0xffff0000u);
                ss += (y[t][j].x * y[t][j].x + y[t][j].y * y[t][j].y) + (y[t][j].z * y[t][j].z + y[t][j].w * y[t][j].w); }
            float eps_r = EPS;
            if (ASQ)
                eps_r = EPS * ((((q0[t].x + q0[t].y) + (q0[t].z + q0[t].w)) + ((q1[t].x + q1[t].y) + (q1[t].z + q1[t].w))) * (1.0f / 512.0f) + EPS);
            const float r = 1.0f / sqrtf(wave_sum(ss) * (1.0f / D) + eps_r);
            float s1 = 0.f;
#pragma unroll
            for (int j = 0; j < 4; ++j) { const f32x4 ww = ((const f32x4*)wpost + lane)[64 * j]; f32x4 x1 = bv[t][j] + y[t][j] * r * ww;
                if (OUT_BF16) { u32x2 o; o.x = pk2(x1.x, x1.y); o.y = pk2(x1.z, x1.w); ((u32x2*)((bf16_t*)outp + row * D) + lane)[64 * j] = o;
                    x1.x = __uint_as_float(o.x << 16); x1.y = __uint_as_float(o.x & 0xffff0000u); x1.z = __uint_as_float(o.y << 16); x1.w = __uint_as_float(o.y & 0xffff0000u); }
                else __builtin_nontemporal_store(x1, (f32x4*)((float*)outp + row * D) + lane + 64 * j);
                s1 += (x1.x * x1.x + x1.y * x1.y) + (x1.z * x1.z + x1.w * x1.w); }
            if (rnext) { s1 = wave_sum(s1); if (lane == 0) rnext[row] = 1.0f / sqrtf(s1 * (1.0f / D) + EPS); }
        }
    }
}

DI void rope8(bf16x8 lo, bf16x8 hi, const f32x2* tab, float sc, float (&o1)[8], float (&o2)[8]) {
    const f32x4* t4 = (const f32x4*)tab;
#pragma unroll
    for (int i = 0; i < 4; ++i) { const f32x4 cs = t4[i];
        { const float x1 = bf2f(lo[2 * i]), x2 = bf2f(hi[2 * i]); o1[2 * i] = (x1 * cs.x - x2 * cs.y) * sc; o2[2 * i] = (x1 * cs.y + x2 * cs.x) * sc; }
        { const float x1 = bf2f(lo[2 * i + 1]), x2 = bf2f(hi[2 * i + 1]); o1[2 * i + 1] = (x1 * cs.z - x2 * cs.w) * sc; o2[2 * i + 1] = (x1 * cs.w + x2 * cs.z) * sc; } }
}
DI void rope8t(bf16x8 lo, bf16x8 hi, const f32x4 (&t4)[4], float sc, float (&o1)[8], float (&o2)[8]) {
#pragma unroll
    for (int i = 0; i < 4; ++i) { const f32x4 cs = t4[i];
        { const float x1 = bf2f(lo[2 * i]), x2 = bf2f(hi[2 * i]); o1[2 * i] = (x1 * cs.x - x2 * cs.y) * sc; o2[2 * i] = (x1 * cs.y + x2 * cs.x) * sc; }
        { const float x1 = bf2f(lo[2 * i + 1]), x2 = bf2f(hi[2 * i + 1]); o1[2 * i + 1] = (x1 * cs.z - x2 * cs.w) * sc; o2[2 * i + 1] = (x1 * cs.w + x2 * cs.z) * sc; } }
}
DI bf16x8 pack8(const float (&v)[8]) { u32x4 w; w.x = pk2(v[0], v[1]); w.y = pk2(v[2], v[3]); w.z = pk2(v[4], v[5]); w.w = pk2(v[6], v[7]); return __builtin_bit_cast(bf16x8, w); }
DI bf16x8 pack44(f32x4 a, f32x4 b) { u32x4 w; w.x = pk2(a.x, a.y); w.y = pk2(a.z, a.w); w.z = pk2(b.x, b.y); w.w = pk2(b.z, b.w); return __builtin_bit_cast(bf16x8, w); }
DI bf16x8 ld8(const bf16_t* p) { return *(const bf16x8*)p; }
DI bf16x8 lds8(ldsp p) { return *(const LAS bf16x8*)p; }
DI bf16x8 lds44(ldsp p0, ldsp p1) { const bf16x4 a = *(const LAS bf16x4*)p0, b = *(const LAS bf16x4*)p1; return __builtin_shufflevector(a, b, 0, 1, 2, 3, 4, 5, 6, 7); }
DI void sts8(ldsp p, bf16x8 v) { *(LAS bf16x8*)p = v; }
DI void sts1(ldsp p, short v) { *(LAS short*)p = v; }
DI unsigned short f2bf1(float f) { return (unsigned short)(pk2(f, 0.f) & 0xffffu); }

constexpr int WA_KSTR = 144, WA_VSTR = 1040, WA_VOFF = 512 * WA_KSTR;
template <int QLO, int QHI>
DI void wa_chunk(ldsp lds, int kb, int ch, int half, int n, int fr, int fq, const bf16x8 (&qf)[4][2], f32x4 (&O)[4][4], float (&mrun)[4], float (&lsum)[4], const int (&klo_)[4], const int (&krng)[4]) {
                f32x4 sc[2][4];
#pragma unroll
                for (int kt = 0; kt < 2; ++kt)
#pragma unroll
                    for (int qt = QLO; qt < QHI; ++qt) sc[kt][qt] = (f32x4){0.f, 0.f, 0.f, 0.f};
#pragma unroll
                for (int kt = 0; kt < 2; ++kt)
#pragma unroll
                    for (int ks = 0; ks < 2; ++ks) { const bf16x8 kf = lds8(lds + (kb + ch * 32 + kt * 16 + fr) * WA_KSTR + ks * 64 + fq * 16);
#pragma unroll
                        for (int qt = QLO; qt < QHI; ++qt) sc[kt][qt] = MFMA16(kf, qf[qt][ks], sc[kt][qt]); }
                bf16x8 pf[4];
                const bool interior = (32 * ch >= 64 * half + 63) && (32 * ch + 31 <= 64 * half + 256) && (n > 0 || ch >= 4) && (n < 63 || ch < 8);
                if (!interior) {
#pragma unroll
                    for (int qt = QLO; qt < QHI; ++qt) {
                        const int t = ch * 32 + 4 * fq - klo_[qt];
#pragma unroll
                        for (int kt = 0; kt < 2; ++kt)
#pragma unroll
                            for (int i = 0; i < 4; ++i) sc[kt][qt][i] = ((unsigned)(t + kt * 16 + i) <= (unsigned)krng[qt]) ? sc[kt][qt][i] : -INFINITY; }
                }
#pragma unroll
                for (int qt = QLO; qt < QHI; ++qt) { float mx = -INFINITY;
#pragma unroll
                    for (int kt = 0; kt < 2; ++kt)
#pragma unroll
                        for (int i = 0; i < 4; ++i) mx = fmaxf(mx, sc[kt][qt][i]);
                    mx = fmaxf(mx, __shfl_xor(mx, 16)); mx = fmaxf(mx, __shfl_xor(mx, 32));
                    if (__builtin_amdgcn_ballot_w64(mx > mrun[qt] + 8.0f) != 0ull) {
                        const float mn = fmaxf(mrun[qt], mx), alpha = ex2(mrun[qt] - mn); mrun[qt] = mn; lsum[qt] *= alpha;
#pragma unroll
                        for (int dt = 0; dt < 4; ++dt) O[dt][qt] = O[dt][qt] * alpha; }
                    const float mn = mrun[qt]; float ps = 0.f;
#pragma unroll
                    for (int kt = 0; kt < 2; ++kt)
#pragma unroll
                        for (int i = 0; i < 4; ++i) { const float p = ex2(sc[kt][qt][i] - mn); sc[kt][qt][i] = p; ps += p; }
                    lsum[qt] += ps;
                    pf[qt] = pack44(sc[0][qt], sc[1][qt]); }
#pragma unroll
                for (int dt = 0; dt < 4; ++dt) { ldsp vp = lds + WA_VOFF + (dt * 16 + fr) * WA_VSTR + (kb + ch * 32 + 4 * fq) * 2; const bf16x8 vf = lds44(vp, vp + 32);
#pragma unroll
                    for (int qt = QLO; qt < QHI; ++qt) O[dt][qt] = MFMA16(vf, pf[qt], O[dt][qt]); }
            }

DI void wattn_phase(const Args& a, ldsp lds, int wave, int lane) {
    const bf16_t* Z = (const bf16_t*)(a.ws + WS_Z); bf16_t* MC = (bf16_t*)(a.ws + WS_MIXCAT);
    const f32x2* R64 = (const f32x2*)(a.ws + WS_ROPE64);
    const int tid = threadIdx.x, fr = lane & 15, fq = lane >> 4;
    for (int item = blockIdx.x; item < NB * 2 * 32; item += gridDim.x) {
        const int b = item >> 6, kvh = (item >> 5) & 1, n0 = 2 * (item & 31);
        __syncthreads();
        {
            int ts = tid; asm volatile("" : "+v"(ts));
            bf16x8 klo[4], khi[4], v0[4], v1[4]; f32x4 tb[4][4]; bool ok[4], okv[4];
#pragma unroll
            for (int k = 0; k < 4; ++k) { const int task = ts + 512 * k, r = task >> 2, c = task & 3, kpos = 128 * (n0 - 1) + r; ok[k] = (kpos >= 0 && kpos < S); const int kp = ok[k] ? kpos : 0;
                const bf16_t* p = Z + (size_t)(b * S + kp) * ZLD + ZK + kvh * 64 + 8 * c; klo[k] = ld8(p); khi[k] = ld8(p + 32);
                const f32x4* t4 = (const f32x4*)(R64 + kp * 32 + 8 * c);
#pragma unroll
                for (int i = 0; i < 4; ++i) tb[k][i] = t4[i]; }
#pragma unroll
            for (int k = 0; k < 4; ++k) { const int task = ts + 512 * k, p = task & 255, c = task >> 8, kpos = 128 * (n0 - 1) + 2 * p; okv[k] = (kpos >= 0 && kpos < S); const int kp = okv[k] ? kpos : 0;
                const bf16_t* vp = Z + (size_t)(b * S + kp) * ZLD + ZV + kvh * 64 + 8 * c; v0[k] = ld8(vp); v1[k] = ld8(vp + ZLD); }
#pragma unroll
            for (int k = 0; k < 4; ++k) { const int task = ts + 512 * k, r = task >> 2, c = task & 3; float o1[8], o2[8];
                rope8t(klo[k], khi[k], tb[k], ok[k] ? 1.0f : 0.0f, o1, o2);
                sts8(lds + r * WA_KSTR + 16 * c, pack8(o1)); sts8(lds + r * WA_KSTR + 64 + 16 * c, pack8(o2)); }
#pragma unroll
            for (int k = 0; k < 4; ++k) { const int task = ts + 512 * k, p = task & 255, c = task >> 8;
#pragma unroll
                for (int i = 0; i < 8; ++i) { const unsigned w = (unsigned)(unsigned short)v0[k][i] | ((unsigned)(unsigned short)v1[k][i] << 16);
                    *(LAS unsigned*)(lds + WA_VOFF + ((c >> 2) * 32 + 16 * (i >> 2) + 4 * (c & 3) + (i & 3)) * WA_VSTR + 4 * p) = okv[k] ? w : 0u; } }
        }
        __syncthreads();
        const int g = wave >> 1, half = wave & 1, head = kvh * 4 + g;
        const float sink2 = a.in[5][head] * LOG2E;
        for (int u2 = 0; u2 < 2; ++u2) {
            const int n = n0 + u2, kb = 128 * u2;
            bf16x8 qf[4][2];
#pragma unroll
            for (int qt = 0; qt < 4; ++qt) { const int spos = 128 * n + 64 * half + 16 * qt + fr;
                const bf16_t* p = Z + (size_t)(b * S + spos) * ZLD + ZQ + head * 64 + 8 * fq; float o1[8], o2[8];
                rope8(ld8(p), ld8(p + 32), R64 + spos * 32 + 8 * fq, 0.125f * LOG2E, o1, o2); qf[qt][0] = pack8(o1); qf[qt][1] = pack8(o2); }
            float mrun[4], lsum[4]; f32x4 O[4][4]; int klo_[4], krng[4];
#pragma unroll
            for (int qt = 0; qt < 4; ++qt) { const int qi = 64 * half + 16 * qt + fr; const int lo_ = max(qi, n == 0 ? 128 : 0), hi_ = min(qi + 256, n == 63 ? 255 : 383); klo_[qt] = lo_; krng[qt] = hi_ - lo_; }
#pragma unroll
            for (int qt = 0; qt < 4; ++qt) { mrun[qt] = sink2; lsum[qt] = (fq == 0) ? 1.0f : 0.0f;
#pragma unroll
                for (int dt = 0; dt < 4; ++dt) O[dt][qt] = (f32x4){0.f, 0.f, 0.f, 0.f}; }
            wa_chunk<0, 2>(lds, kb, 2 * half, half, n, fr, fq, qf, O, mrun, lsum, klo_, krng);
            for (int ch = 2 * half + 1; ch < 2 * half + 9; ++ch) wa_chunk<0, 4>(lds, kb, ch, half, n, fr, fq, qf, O, mrun, lsum, klo_, krng);
            wa_chunk<2, 4>(lds, kb, 2 * half + 9, half, n, fr, fq, qf, O, mrun, lsum, klo_, krng);
#pragma unroll
            for (int qt = 0; qt < 4; ++qt) { float l = lsum[qt]; l += __shfl_xor(l, 16); l += __shfl_xor(l, 32); const float inv = 1.0f / l;
                const int spos = 128 * n + 64 * half + 16 * qt + fr; bf16_t* op = MC + (size_t)(b * S + spos) * D + head * 64 + 8 * fq; float sq = 0.f;
#pragma unroll
                for (int j = 0; j < 2; ++j) { f32x4 o0 = O[2 * j][qt] * inv, o1 = O[2 * j + 1][qt] * inv;
                    sq += ((o0.x * o0.x + o0.y * o0.y) + (o0.z * o0.z + o0.w * o0.w)) + ((o1.x * o1.x + o1.y * o1.y) + (o1.z * o1.z + o1.w * o1.w));
                    o0 = o0 * *(const f32x4*)(a.in[6] + head * 64 + 32 * j + 8 * fq); o1 = o1 * *(const f32x4*)(a.in[6] + head * 64 + 32 * j + 8 * fq + 4);
                    u32x4 w; w.x = pk2(o0.x, o0.y); w.y = pk2(o0.z, o0.w); w.z = pk2(o1.x, o1.y); w.w = pk2(o1.z, o1.w); *(u32x4*)(op + 32 * j) = w; }
                sq += __shfl_xor(sq, 16); sq += __shfl_xor(sq, 32);
                if (fq == 0) ((float*)(a.ws + WS_ASQ))[(size_t)(b * S + spos) * 8 + head] = sq; }
        }
    }
}

constexpr int RT_STR = 272;
constexpr int RT_TILE = 128 * RT_STR;
DI void ret_lg2(const Args& a, int h, float& l2f, float& l2b) {
    l2f = -log1pf(expf(-a.in[7][h])) * LOG2E; l2b = -log1pf(expf(-a.in[8][h])) * LOG2E;
}
DI void ret_ld_vt(const bf16_t* VTR, int b, int h, int n, int tid, bf16x8 (&v)[4]) {
#pragma unroll
    for (int k = 0; k < 4; ++k) { const int task = tid + 512 * k, r = task >> 4, c = task & 15; v[k] = ld8(VTR + (size_t)(h * 128 + r) * VTR_LD + b * S + 128 * n + 8 * c); }
}
DI void ret_ld_tile(const bf16_t* src, int tid, bf16x8 (&v)[4]) {
#pragma unroll
    for (int k = 0; k < 4; ++k) { const int task = tid + 512 * k, r = task >> 4, c = task & 15; v[k] = ld8(src + r * 128 + 8 * c); }
}
template <bool PERM = false>
DI void ret_st_tile(ldsp dst, int tid, const bf16x8 (&v)[4]) {
#pragma unroll
    for (int k = 0; k < 4; ++k) { const int task = tid + 512 * k, r = task >> 4, c = task & 15; const int sl = PERM ? (r & ~31) + 16 * ((r >> 2) & 1) + 4 * ((r >> 3) & 3) + (r & 3) : r;
        sts8(dst + sl * RT_STR + 16 * c, v[k]); }
}
DI void ret_kv_phase(const Args& a, ldsp lds, int wave, int lane) {
    const bf16_t* Z = (const bf16_t*)(a.ws + WS_Z); const bf16_t* VTR = (const bf16_t*)(a.ws + WS_VTR); bf16_t* KVI = (bf16_t*)(a.ws + WS_KVI);
    const f32x2* R128 = (const f32x2*)(a.ws + WS_ROPE128);
    const int tid = threadIdx.x, fr = lane & 15, fq = lane >> 4;
    constexpr int NU = NB * 4 * 64;
    const int p = tid & 63, c = tid >> 6;
    bf16x8 vv[4], k0lo, k0hi, k1lo, k1hi; f32x4 tb0[4], tb1[4];
#define RKV_LOAD(u) do { const int b_ = (u) >> 8, h_ = ((u) >> 6) & 3, n_ = (u) & 63, sp_ = 128 * n_ + 2 * p; \
        ret_ld_vt(VTR, b_, h_, n_, tid, vv); \
        const bf16_t* kp_ = Z + (size_t)(b_ * S + sp_) * ZLD + ZRK + h_ * 128 + 8 * c; k0lo = ld8(kp_); k0hi = ld8(kp_ + 64); k1lo = ld8(kp_ + ZLD); k1hi = ld8(kp_ + ZLD + 64); \
        const f32x4* t0_ = (const f32x4*)(R128 + sp_ * 64 + 8 * c); const f32x4* t1_ = (const f32x4*)(R128 + (sp_ + 1) * 64 + 8 * c); \
        _Pragma("unroll") for (int i_ = 0; i_ < 4; ++i_) { tb0[i_] = t0_[i_]; tb1[i_] = t1_[i_]; } } while (0)
    int unit = blockIdx.x;
    if (unit < NU) RKV_LOAD(unit);
    for (; unit < NU; unit += gridDim.x) {
        const int b = unit >> 8, h = (unit >> 6) & 3, n = unit & 63;
        float l2f, l2b; ret_lg2(a, h, l2f, l2b);
        __syncthreads();
        {
            float a1[8], a2[8], b1[8], b2[8];
            rope8t(k0lo, k0hi, tb0, 0.08838834764831845f, a1, a2); rope8t(k1lo, k1hi, tb1, 0.08838834764831845f, b1, b2);
            const float wf0 = ex2((float)(127 - 2 * p) * l2f), wf1 = ex2((float)(126 - 2 * p) * l2f), wb0 = ex2((float)(2 * p) * l2b), wb1 = ex2((float)(2 * p + 1) * l2b);
#pragma unroll
            for (int i = 0; i < 8; ++i) {
                const int sl = (c >> 2) * 32 + 16 * (i >> 2) + 4 * (c & 3) + (i & 3);
                *(LAS unsigned*)(lds + RT_TILE + sl * RT_STR + 4 * p) = pk2(a1[i] * wf0, b1[i] * wf1); *(LAS unsigned*)(lds + RT_TILE + (64 + sl) * RT_STR + 4 * p) = pk2(a2[i] * wf0, b2[i] * wf1);
                *(LAS unsigned*)(lds + 2 * RT_TILE + sl * RT_STR + 4 * p) = pk2(a1[i] * wb0, b1[i] * wb1); *(LAS unsigned*)(lds + 2 * RT_TILE + (64 + sl) * RT_STR + 4 * p) = pk2(a2[i] * wb0, b2[i] * wb1); }
        }
        ret_st_tile(lds, tid, vv);
        __syncthreads();
        { const int nu = unit + (int)gridDim.x; if (nu < NU) RKV_LOAD(nu); }
        const int dkb = (wave & 3) * 32, dvb = (wave >> 2) * 64;
        f32x4 acc[2][2][4];
#pragma unroll
        for (int d = 0; d < 2; ++d)
#pragma unroll
            for (int x = 0; x < 2; ++x)
#pragma unroll
                for (int t = 0; t < 4; ++t) acc[d][x][t] = (f32x4){0.f, 0.f, 0.f, 0.f};
#pragma unroll
        for (int ks = 0; ks < 4; ++ks) {
            bf16x8 kf[2][2];
#pragma unroll
            for (int d = 0; d < 2; ++d)
#pragma unroll
                for (int x = 0; x < 2; ++x) kf[d][x] = lds8(lds + (1 + d) * RT_TILE + (dkb + 16 * x + fr) * RT_STR + ks * 64 + fq * 16);
#pragma unroll
            for (int t = 0; t < 4; ++t) { const bf16x8 vf = lds8(lds + (dvb + 16 * t + fr) * RT_STR + ks * 64 + fq * 16);
#pragma unroll
                for (int d = 0; d < 2; ++d)
#pragma unroll
                    for (int x = 0; x < 2; ++x) acc[d][x][t] = MFMA16(kf[d][x], vf, acc[d][x][t]); }
        }
#pragma unroll
        for (int d = 0; d < 2; ++d) { bf16_t* sp = KVI + ((size_t)(((b * 4 + h) * 2 + d) * 64 + n)) * 16384;
#pragma unroll
            for (int t = 0; t < 4; ++t) { u32x4 w; w.x = pk2(acc[d][0][t].x, acc[d][0][t].y); w.y = pk2(acc[d][0][t].z, acc[d][0][t].w); w.z = pk2(acc[d][1][t].x, acc[d][1][t].y); w.w = pk2(acc[d][1][t].z, acc[d][1][t].w);
                *(u32x4*)(sp + (dvb + 16 * t + fr) * 128 + dkb + 8 * fq) = w; } }
    }
#undef RKV_LOAD
}
DI void scan_phase(const Args& a, int wave, int lane) {
    const int gt = blockIdx.x * 512 + threadIdx.x, NT = gridDim.x * 512;
    for (int idx = gt; idx < 32 * 4096; idx += NT) {
        const int bhd = idx >> 12, e4 = idx & 4095, dir = bhd & 1, h = (bhd >> 1) & 3;
        float l2f, l2b; ret_lg2(a, h, l2f, l2b);
        const float decay = ex2(128.0f * (dir ? l2b : l2f));
        const u32x2* src = (const u32x2*)(a.ws + WS_KVI) + (size_t)bhd * 64 * 4096 + e4;
        u32x2* dst = (u32x2*)(a.ws + WS_PRV) + (size_t)bhd * 64 * 4096 + e4;
        f32x4 st = {0.f, 0.f, 0.f, 0.f};
        for (int it = 0; it < 64; it += 16) {
            u32x2 kv[16];
#pragma unroll
            for (int j = 0; j < 16; ++j) { const int n = dir ? 63 - (it + j) : it + j; kv[j] = src[(size_t)n * 4096]; }
#pragma unroll
            for (int j = 0; j < 16; ++j) { const int n = dir ? 63 - (it + j) : it + j; u32x2 o; o.x = pk2(st.x, st.y); o.y = pk2(st.z, st.w); dst[(size_t)n * 4096] = o;
                const f32x4 k4 = {__uint_as_float(kv[j].x << 16), __uint_as_float(kv[j].x & 0xffff0000u), __uint_as_float(kv[j].y << 16), __uint_as_float(kv[j].y & 0xffff0000u)};
                st = st * decay + k4; }
        }
    }
}
DI void anorm_phase(const Args& a, int wave, int lane) {
    bf16_t* MC = (bf16_t*)(a.ws + WS_MIXCAT);
    const int gw = blockIdx.x * 8 + wave, NGW = gridDim.x * 8;
    for (int row = gw; row < T; row += NGW) {
        bf16_t* p = MC + (size_t)row * D + 8 * lane; const bf16x8 v = ld8(p); float x[8], ss = 0.f;
#pragma unroll
        for (int i = 0; i < 8; ++i) { x[i] = bf2f(v[i]); ss += x[i] * x[i]; }
        const float r = 1.0f / sqrtf(wave_sum(ss) * (1.0f / 512.0f) + EPS);
        const f32x4 w0 = *(const f32x4*)(a.in[6] + 8 * lane), w1 = *(const f32x4*)(a.in[6] + 8 * lane + 4);
        x[0] *= r * w0.x; x[1] *= r * w0.y; x[2] *= r * w0.z; x[3] *= r * w0.w; x[4] *= r * w1.x; x[5] *= r * w1.y; x[6] *= r * w1.z; x[7] *= r * w1.w;
        *(bf16x8*)p = pack8(x);
    }
}
DI void ret_out_phase(const Args& a, ldsp lds, int wave, int lane) {
    const bf16_t* Z = (const bf16_t*)(a.ws + WS_Z); const bf16_t* VTR = (const bf16_t*)(a.ws + WS_VTR); const bf16_t* PRV = (const bf16_t*)(a.ws + WS_PRV); bf16_t* MC = (bf16_t*)(a.ws + WS_MIXCAT);
    const f32x2* R128 = (const f32x2*)(a.ws + WS_ROPE128);
    const int tid = threadIdx.x, fr = lane & 15, fq = lane >> 4;
    constexpr int NU = NB * 4 * 64;
    bf16x8 vv[4], pf_[4], pb_[4], klo[2], khi[2];
#define ROUT_LOAD(u) do { const int b_ = (u) >> 8, h_ = ((u) >> 6) & 3, n_ = (u) & 63; int tl_ = tid; asm volatile("" : "+v"(tl_)); \
        ret_ld_vt(VTR, b_, h_, n_, tl_, vv); \
        ret_ld_tile(PRV + ((size_t)(((b_ * 4 + h_) * 2 + 0) * 64 + n_)) * 16384, tl_, pf_); ret_ld_tile(PRV + ((size_t)(((b_ * 4 + h_) * 2 + 1) * 64 + n_)) * 16384, tl_, pb_); \
        _Pragma("unroll") for (int k_ = 0; k_ < 2; ++k_) { const int task_ = tl_ + 512 * k_, r_ = task_ >> 3, c_ = task_ & 7; \
            const bf16_t* p_ = Z + (size_t)(b_ * S + 128 * n_ + r_) * ZLD + ZRK + h_ * 128 + 8 * c_; klo[k_] = ld8(p_); khi[k_] = ld8(p_ + 64); } } while (0)
    int unit = blockIdx.x;
    if (unit < NU) ROUT_LOAD(unit);
    for (; unit < NU; unit += gridDim.x) {
        const int b = unit >> 8, h = (unit >> 6) & 3, n = unit & 63;
        float l2f, l2b; ret_lg2(a, h, l2f, l2b);
        {
            int ts = tid; asm volatile("" : "+v"(ts));
            f32x4 tb[2][4];
#pragma unroll
            for (int k = 0; k < 2; ++k) { const int task = ts + 512 * k, r = task >> 3, c = task & 7; const f32x4* t4 = (const f32x4*)(R128 + (128 * n + r) * 64 + 8 * c);
#pragma unroll
                for (int i = 0; i < 4; ++i) tb[k][i] = t4[i]; }
            __syncthreads();
            ret_st_tile<true>(lds + RT_TILE, ts, vv); ret_st_tile<true>(lds + 2 * RT_TILE, ts, pf_); ret_st_tile<true>(lds + 3 * RT_TILE, ts, pb_);
#pragma unroll
            for (int k = 0; k < 2; ++k) { const int task = ts + 512 * k, r = task >> 3, c = task & 7; float o1[8], o2[8];
                rope8t(klo[k], khi[k], tb[k], 0.08838834764831845f, o1, o2);
                sts8(lds + r * RT_STR + 16 * c, pack8(o1)); sts8(lds + r * RT_STR + 128 + 16 * c, pack8(o2)); }
        }
        const int cl = 16 * wave + fr, spos = 128 * n + cl; const size_t row = (size_t)(b * S + spos);
        bf16x8 qf[4];
#pragma unroll
        for (int ks = 0; ks < 2; ++ks) { const bf16_t* p = Z + row * ZLD + ZRQ + h * 128 + 32 * ks + 8 * fq; float o1[8], o2[8];
            rope8(ld8(p), ld8(p + 64), R128 + spos * 64 + 32 * ks + 8 * fq, 1.0f, o1, o2); qf[ks] = pack8(o1); qf[ks + 2] = pack8(o2); }
        __syncthreads();
        { const int nu = unit + (int)gridDim.x; if (nu < NU) ROUT_LOAD(nu); }
        f32x4 st[8];
#pragma unroll
        for (int mt = 0; mt < 8; ++mt) { st[mt] = (f32x4){0.f, 0.f, 0.f, 0.f};
#pragma unroll
            for (int ks = 0; ks < 4; ++ks) st[mt] = MFMA16(lds8(lds + (16 * mt + fr) * RT_STR + ks * 64 + fq * 16), qf[ks], st[mt]); }
#pragma unroll
        for (int mt = 0; mt < 8; ++mt)
#pragma unroll
            for (int i = 0; i < 4; ++i) { const int m = 16 * mt + 4 * fq + i, dl = cl - m; const float w = dl >= 0 ? ex2((float)dl * l2f) : ex2((float)(-dl) * l2b); st[mt][i] *= w; }
        f32x4 y[8];
#pragma unroll
        for (int dt = 0; dt < 8; ++dt) y[dt] = (f32x4){0.f, 0.f, 0.f, 0.f};
#pragma unroll
        for (int s4 = 0; s4 < 4; ++s4) { const bf16x8 pf = pack44(st[2 * s4], st[2 * s4 + 1]);
#pragma unroll
            for (int dt = 0; dt < 8; ++dt) { ldsp vp = lds + RT_TILE + (16 * dt + fr) * RT_STR + (32 * s4 + 4 * fq) * 2; y[dt] = MFMA16(lds44(vp, vp + 32), pf, y[dt]); } }
        const float wF = ex2((float)(cl + 1) * l2f), wB = ex2((float)(128 - cl) * l2b);
#pragma unroll
        for (int d = 0; d < 2; ++d) { const float wq_ = d ? wB : wF; bf16x8 qs[4];
#pragma unroll
            for (int ks = 0; ks < 4; ++ks) { float t8[8];
#pragma unroll
                for (int i = 0; i < 8; ++i) t8[i] = bf2f(qf[ks][i]) * wq_;
                qs[ks] = pack8(t8); }
#pragma unroll
            for (int ks = 0; ks < 4; ++ks)
#pragma unroll
                for (int dt = 0; dt < 8; ++dt) y[dt] = MFMA16(lds8(lds + (2 + d) * RT_TILE + (16 * dt + fr) * RT_STR + ks * 64 + fq * 16), qs[ks], y[dt]); }
        float sm = 0.f;
#pragma unroll
        for (int dt = 0; dt < 8; ++dt) sm += (y[dt].x + y[dt].y) + (y[dt].z + y[dt].w);
        sm += __shfl_xor(sm, 16); sm += __shfl_xor(sm, 32);
        const float mu = sm * (1.0f / 128.0f); float vs = 0.f;
#pragma unroll
        for (int dt = 0; dt < 8; ++dt) { y[dt] = y[dt] - mu; vs += (y[dt].x * y[dt].x + y[dt].y * y[dt].y) + (y[dt].z * y[dt].z + y[dt].w * y[dt].w); }
        vs += __shfl_xor(vs, 16); vs += __shfl_xor(vs, 32);
        float rs = 1.0f / sqrtf(vs * (1.0f / 128.0f) + EPS);
        {
            const f32x4 q0 = *(const f32x4*)((const float*)(a.ws + WS_ASQ) + row * 8), q1 = *(const f32x4*)((const float*)(a.ws + WS_ASQ) + row * 8 + 4);
            rs *= sqrtf((((q0.x + q0.y) + (q0.z + q0.w)) + ((q1.x + q1.y) + (q1.z + q1.w))) * (1.0f / 512.0f) + EPS); }
#pragma unroll
        for (int j = 0; j < 4; ++j) { const int dv = h * 128 + 32 * j + 8 * fq;
            const u32x4 gu = *(const u32x4*)(Z + row * ZLD + ZRG + dv); const f32x4 gw0 = *(const f32x4*)(a.in[9] + dv), gw1 = *(const f32x4*)(a.in[9] + dv + 4);
            const float g0 = __uint_as_float(gu.x << 16), g1 = __uint_as_float(gu.x & 0xffff0000u), g2 = __uint_as_float(gu.y << 16), g3 = __uint_as_float(gu.y & 0xffff0000u);
            const float g4 = __uint_as_float(gu.z << 16), g5 = __uint_as_float(gu.z & 0xffff0000u), g6 = __uint_as_float(gu.w << 16), g7 = __uint_as_float(gu.w & 0xffff0000u);
            u32x4 w; w.x = pk2(pg8::silu_f(g0) * y[2 * j].x * rs * gw0.x, pg8::silu_f(g1) * y[2 * j].y * rs * gw0.y); w.y = pk2(pg8::silu_f(g2) * y[2 * j].z * rs * gw0.z, pg8::silu_f(g3) * y[2 * j].w * rs * gw0.w);
            w.z = pk2(pg8::silu_f(g4) * y[2 * j + 1].x * rs * gw1.x, pg8::silu_f(g5) * y[2 * j + 1].y * rs * gw1.y); w.w = pk2(pg8::silu_f(g6) * y[2 * j + 1].z * rs * gw1.z, pg8::silu_f(g7) * y[2 * j + 1].w * rs * gw1.w);
            *(u32x4*)(MC + row * D + 512 + dv) = w; }
    }
#undef ROUT_LOAD
}

template <class Epi> DI void run_gemm(ldsp lds, const bf16_t* A, const bf16_t* Bt, int M, int N, int K, const Epi& E, int boff = 0, int lda = 0, int ldb = 0, int ppb = 0, size_t bstrideB = 0) {
    pg8::Gemm g{A, Bt, M, N, K, lda ? lda : K, ldb ? ldb : K, ppb, bstrideB}; pg8::StaticOrder So; So.init(M, N, (int)gridDim.x, (int)((blockIdx.x + gridDim.x - boff) % gridDim.x));
    pg8::gemm_phase<Epi, pg8::StaticOrder, true, true>(lds, g, So, E);
}

__global__ void __launch_bounds__(512, 2) fwd_kernel(Args a) {
    extern __shared__ __attribute__((aligned(16))) unsigned char lds_raw[];
    cg::grid_group grid = cg::this_grid();
    ldsp lds = (ldsp)lds_raw;
    const int tid = threadIdx.x, lane = tid & 63, wave = __builtin_amdgcn_readfirstlane(tid >> 6);
    unsigned char* ws = a.ws;
    const int lo = a.ph_lo, hi = a.ph_hi;
    volatile LAS unsigned* bst = (volatile LAS unsigned*)(lds + LDS_BYTES - 64);
    if (tid < 16) bst[tid] = 0u;
    __syncthreads();
    XcdBarrier bar; bar.bar = (unsigned*)ws; bar.x = 0; bar.st = bst;
    if (hi - lo > 1) bar = xcd_barrier_post((unsigned*)ws, bst);
#define IN(k) (lo <= (k) && (k) < hi)
#define SEAM(k) do { if (IN(k) && IN((k) + 1)) xcd_barrier(bar); } while (0)
    if (lo == 0x7fffffff) grid.sync();
#define PH(k, ...) do { if (IN(k)) { { __syncthreads(); __VA_ARGS__; } } } while (0)
    PH(0, p0_prologue(a, lds, wave, lane));
    SEAM(0);
    PH(1, run_gemm(lds, (const bf16_t*)(ws + WS_H), (const bf16_t*)(ws + WS_WIN), T, ZLD, D, pg8::EpiBf16{(bf16_t*)(ws + WS_Z), ZLD, 1.0f, (const float*)(ws + WS_R0), nullptr});
          __syncthreads();
          run_gemm(lds, (const bf16_t*)(ws + WS_MN), (const bf16_t*)(ws + WS_WKV), MT, 2 * D, D, pg8::EpiBf16{(bf16_t*)(ws + WS_KVM), 2 * D, 1.0f, nullptr, nullptr}, 128);
          __syncthreads();
          run_gemm(lds, (const bf16_t*)(ws + WS_WIN) + (size_t)ZLD * D, (const bf16_t*)(ws + WS_H), 512, T, D, pg8::EpiBf16{(bf16_t*)(ws + WS_VTR), VTR_LD, 1.0f, nullptr, (const float*)(ws + WS_R0)});
          if (gridDim.x == 256 && blockIdx.x >= 160) { __syncthreads(); p1_late_weights(a, lds, (int)(blockIdx.x - 160) * 8 + wave, 96 * 8, wave, lane); }
          else if (gridDim.x != 256) { __syncthreads(); p1_late_weights(a, lds, (int)blockIdx.x * 8 + wave, (int)gridDim.x * 8, wave, lane); });
    SEAM(1);
    PH(2, if (blockIdx.x < 128) {
              const int ci = blockIdx.x >> 2, b_ = (ci >> 2) & 3, h_ = ci & 3; const bf16_t* kvm = (const bf16_t*)(ws + WS_KVM) + (size_t)(b_ * NMEM) * 2 * D + h_ * 256;
              if (ci < 16) run_gemm(lds, kvm, (const bf16_t*)(ws + WS_WQ) + h_ * 256, 256, D, 256, pg8::EpiBf16{(bf16_t*)(ws + WS_GT) + (size_t)(b_ * D + h_ * 256) * D, D, 1.0f, nullptr, nullptr}, 4 * ci, 2 * D, D);
              else run_gemm(lds, (const bf16_t*)(ws + WS_WO) + h_ * 256, kvm + D, D, 256, 256, pg8::EpiBf16{(bf16_t*)(ws + WS_UT) + (size_t)b_ * D * D + h_ * 256, D, 1.0f, nullptr, nullptr}, 4 * ci, D, 2 * D);
              __syncthreads(); }
          wattn_phase(a, lds, wave, lane); ret_kv_phase(a, lds, wave, lane));
    SEAM(2);
    PH(3, scan_phase(a, wave, lane));
    SEAM(3);
    PH(4, ret_out_phase(a, lds, wave, lane));
    SEAM(4);
    PH(5, run_gemm(lds, (const bf16_t*)(ws + WS_MIXCAT), (const bf16_t*)(ws + WS_WOUT), T, D, D, pg8::EpiBf16{(bf16_t*)(ws + WS_MIXO), D, 1.0f, nullptr, nullptr}));
    SEAM(5);
    PH(6, rowwise_phase<true, true, true>((const bf16_t*)(ws + WS_MIXO), ws + WS_H, a.in[3], ws + WS_XB, (float*)(ws + WS_R1), wave, lane, (const float*)(ws + WS_ASQ)));
    SEAM(6);
    PH(7, run_gemm(lds, (const bf16_t*)(ws + WS_XB), (const bf16_t*)(ws + WS_GT), T, D, D, pg8::EpiSoftmax{(bf16_t*)(ws + WS_Q), D, (const float*)(ws + WS_R1), lds + 131072}, 0, 0, 0, S / 256, (size_t)D * D));
    SEAM(7);
    PH(8, run_gemm(lds, (const bf16_t*)(ws + WS_Q), (const bf16_t*)(ws + WS_UT), T, D, D, pg8::EpiBf16{(bf16_t*)(ws + WS_XO), D, 1.0f, nullptr, nullptr}, 0, 0, 0, S / 256, (size_t)D * D));
    SEAM(9);
    PH(10, rowwise_phase<true, true>((const bf16_t*)(ws + WS_XO), ws + WS_XB, a.in[12], ws + WS_XB, (float*)(ws + WS_R2), wave, lane));
    SEAM(10);
    PH(11, run_gemm(lds, (const bf16_t*)(ws + WS_XB), (const bf16_t*)(ws + WS_WGU), T, 2 * FF, D, pg8::EpiSwiglu{(bf16_t*)(ws + WS_F), FF, (const float*)(ws + WS_R2)}));
    SEAM(11);
    PH(12, run_gemm(lds, (const bf16_t*)(ws + WS_F), (const bf16_t*)(ws + WS_WDN), T, D, FF, pg8::EpiBf16{(bf16_t*)(ws + WS_DN), D, 1.0f, nullptr, nullptr}));
    SEAM(12);
    PH(13, rowwise_phase<true, false>((const bf16_t*)(ws + WS_DN), ws + WS_XB, a.in[18], a.out, nullptr, wave, lane));
    PH(14, wattn_phase(a, lds, wave, lane)); PH(15, ret_kv_phase(a, lds, wave, lane)); PH(16, scan_phase(a, wave, lane)); PH(17, anorm_phase(a, wave, lane));
#undef PH
#undef IN
#undef SEAM
}
}

#ifndef MK_N_LAUNCHES
#define MK_N_LAUNCHES 1
#endif
extern "C" void kernel_launch(void* const* d_in, const int* in_sizes, int n_in, void* d_out, int out_size, void* d_ws, size_t ws_size, hipStream_t stream) {
    using namespace mk;
    static int grid = 0;
    if (grid == 0) {
        if (n_in != 21 || in_sizes[0] != T * D || out_size != T * D || ws_size < WS_END) { fprintf(stderr, "kernel_launch: unexpected shapes (n_in %d, in0 %d, out %d, ws %zu)\n", n_in, n_in > 0 ? in_sizes[0] : -1, out_size, ws_size); grid = -1; return; }
        int dev = 0, cus = 0, per_cu = 0;
        if (hipGetDevice(&dev) != hipSuccess || hipDeviceGetAttribute(&cus, hipDeviceAttributeMultiprocessorCount, dev) != hipSuccess) { grid = -1; return; }
        if (hipFuncSetAttribute((const void*)fwd_kernel, hipFuncAttributeMaxDynamicSharedMemorySize, LDS_BYTES) != hipSuccess) { fprintf(stderr, "kernel_launch: hipFuncSetAttribute failed\n"); grid = -1; return; }
        if (hipOccupancyMaxActiveBlocksPerMultiprocessor(&per_cu, (const void*)fwd_kernel, 512, LDS_BYTES) != hipSuccess || per_cu < 1) { fprintf(stderr, "kernel_launch: occupancy query says %d\n", per_cu); per_cu = 1; }
        (void)hipGetLastError();
        grid = cus;
    }
    if (grid < 0) return;
    Args a{};
    for (int i = 0; i < 21; ++i) a.in[i] = (const float*)d_in[i];
    a.out = (float*)d_out; a.ws = (unsigned char*)d_ws;
#if MK_N_LAUNCHES == 1
    a.ph_lo = 0; a.ph_hi = NPH;
    if (hipMemsetAsync(d_ws, 0, 16384, stream) != hipSuccess) { fprintf(stderr, "kernel_launch: memset of the barrier words failed\n"); return; }
    void* args[] = {&a};
    hipError_t e = hipLaunchCooperativeKernel((const void*)fwd_kernel, dim3(grid), dim3(512), args, LDS_BYTES, stream);
    if (e != hipSuccess) fprintf(stderr, "cooperative launch failed: %s (grid %d)\n", hipGetErrorString(e), grid);
#else
    for (int k = 0; k < NPH; ++k) { a.ph_lo = k; a.ph_hi = k + 1; hipLaunchKernelGGL(fwd_kernel, dim3(grid), dim3(512), LDS_BYTES, stream, a); }
    for (int k = 0; k < 18; ++k) if ((REP_MASK >> k) & 1) for (int rep = 0; rep < 4; ++rep) { a.ph_lo = k; a.ph_hi = k + 1; hipLaunchKernelGGL(fwd_kernel, dim3(grid), dim3(512), LDS_BYTES, stream, a); }
#endif
}
```

```cpp
#include <hip/hip_runtime.h>
#include <hip/hip_cooperative_groups.h>
#include <cstdio>
#include <cstdint>
#include <cmath>
namespace cg = cooperative_groups;
namespace pg8 {
#define PG8_LAS __attribute__((address_space(3)))
typedef unsigned short bf16_t;
typedef short bf16x8 __attribute__((ext_vector_type(8)));
typedef float f32x4 __attribute__((ext_vector_type(4)));
typedef unsigned u32x4 __attribute__((ext_vector_type(4)));
constexpr int BM = 256, BK = 64, HALF = 128, HTB = HALF * BK * 2  , STAGE_BYTES = 8 * HTB, NXCD = 8, WGM = 4;

__host__ __device__ __forceinline__ int lds_byte(int r, int c) { const int st = (r >> 4) * 2 + (c >> 5), rr = r & 15, cc = c & 31, ob = rr * 64 + cc * 2; return st * 1024 + (ob ^ (((ob >> 9) & 1) << 5)); }
__host__ __device__ __forceinline__ void stage_rc(int b, int& R, int& C) { const int st = b / 1024, sb = b % 1024, swz = sb ^ (((sb >> 9) & 1) << 5); R = (st >> 1) * 16 + swz / 64; C = (st & 1) * 32 + (swz % 64) / 2; }
__host__ __device__ __forceinline__ int perm32(int rho) { const int n = rho >> 4, i = rho & 15; return 8 * (i >> 2) + 4 * n + (i & 3); }

struct Unit { int pm, pn; };
struct Gemm { const bf16_t* A; const bf16_t* Bt; int M, N, K; int lda, ldb; int ppb; size_t bstrideB; };

struct StaticOrder {
    int nM, nN, nwg, G, c;
    __host__ __device__ void init(int M, int N, int G_, int c_) { nM = M / BM; nN = N / BM; nwg = nM * nN; G = G_; c = c_; }
    __host__ __device__ bool next(int i, Unit& u) const {
        const long L = (long)i * G + c; if (L >= nwg) return false;
        int wgid = (int)L; { const int q = nwg / NXCD, r = nwg % NXCD, xcd = wgid % NXCD, off = wgid / NXCD; wgid = (xcd < r ? xcd * (q + 1) : r * (q + 1) + (xcd - r) * q) + off; }
        const int nig = WGM * nN, gid = wgid / nig, fm = gid * WGM, gsz = (nM - fm) < WGM ? (nM - fm) : WGM;
        u.pm = fm + ((wgid % nig) % gsz); u.pn = (wgid % nig) / gsz; return true;
    }
    __device__ __forceinline__ void a_ready(const Unit&) const {}
    __device__ __forceinline__ void done(const Unit&) const {}
};

typedef __bf16 bf16v2 __attribute__((ext_vector_type(2)));
__device__ __forceinline__ unsigned cvt_pk_bf16(float lo, float hi) { bf16v2 v = {(__bf16)lo, (__bf16)hi}; return __builtin_bit_cast(unsigned, v); }
struct EpiBf16 {
    static constexpr bool PERM = true, AFTER_DRAIN = false;
    bf16_t* O; int ldc; float sc; const float* rs; const float* cs;
    __device__ __forceinline__ void operator()(const f32x4 (&acc)[2][2][4][2], const Unit& u, int wr, int wc, int fr, int fq) const {
        const int row0 = u.pm * BM + wr * 64 + fr; const int col0 = u.pn * BM + wc * 32 + 8 * fq;
        f32x4 c0[2], c1[2];
#pragma unroll
        for (int bj = 0; bj < 2; ++bj) { c0[bj] = (f32x4){sc, sc, sc, sc}; c1[bj] = c0[bj];
            if (cs) { c0[bj] = c0[bj] * *(const f32x4*)(cs + col0 + bj * HALF); c1[bj] = c1[bj] * *(const f32x4*)(cs + col0 + bj * HALF + 4); } }
#pragma unroll
        for (int ai = 0; ai < 2; ++ai)
#pragma unroll
            for (int m = 0; m < 4; ++m) { bf16_t* rowp = O + (size_t)(row0 + ai * HALF + m * 16) * ldc + col0; const float rr = rs ? rs[row0 + ai * HALF + m * 16] : 1.0f;
#pragma unroll
                for (int bj = 0; bj < 2; ++bj) { f32x4 v0 = acc[ai][bj][m][0] * (c0[bj] * rr), v1 = acc[ai][bj][m][1] * (c1[bj] * rr);
                    u32x4 w; w.x = cvt_pk_bf16(v0[0], v0[1]); w.y = cvt_pk_bf16(v0[2], v0[3]); w.z = cvt_pk_bf16(v1[0], v1[1]); w.w = cvt_pk_bf16(v1[2], v1[3]);
                    *(u32x4*)(rowp + bj * HALF) = w; } }
    }
};
struct EpiSoftmax {
    static constexpr bool PERM = true, AFTER_DRAIN = false;
    bf16_t* O; int ldc; const float* rs; PG8_LAS unsigned char* scr;
    __device__ __forceinline__ void operator()(f32x4 (&acc)[2][2][4][2], const Unit& u, int wr, int wc, int fr, int fq) const {
        const int row0 = u.pm * BM + wr * 64 + fr; const int col0 = u.pn * BM + wc * 32 + 8 * fq;
        PG8_LAS float* PM = (PG8_LAS float*)scr; PG8_LAS float* PS = PM + 1024;
#pragma unroll
        for (int ai = 0; ai < 2; ++ai)
#pragma unroll
            for (int m = 0; m < 4; ++m) { const int rl = ai * HALF + wr * 64 + m * 16 + fr; const float rr = rs[u.pm * BM + rl]; float mx = -INFINITY;
#pragma unroll
                for (int bj = 0; bj < 2; ++bj)
#pragma unroll
                    for (int n = 0; n < 2; ++n) { const f32x4 v = acc[ai][bj][m][n] * rr; acc[ai][bj][m][n] = v; mx = fmaxf(mx, fmaxf(fmaxf(v[0], v[1]), fmaxf(v[2], v[3]))); }
                mx = fmaxf(mx, __shfl_xor(mx, 16)); mx = fmaxf(mx, __shfl_xor(mx, 32));
                if (fq == 0) PM[rl * 4 + wc] = mx; }
        asm volatile("s_waitcnt lgkmcnt(0)" ::: "memory"); __builtin_amdgcn_s_barrier(); asm volatile("" ::: "memory");
#pragma unroll
        for (int ai = 0; ai < 2; ++ai)
#pragma unroll
            for (int m = 0; m < 4; ++m) { const int rl = ai * HALF + wr * 64 + m * 16 + fr; const f32x4 m4 = *(const PG8_LAS f32x4*)(PM + rl * 4);
                const float mrow = fmaxf(fmaxf(m4[0], m4[1]), fmaxf(m4[2], m4[3])); float sm = 0.f;
#pragma unroll
                for (int bj = 0; bj < 2; ++bj)
#pragma unroll
                    for (int n = 0; n < 2; ++n) { f32x4 v = acc[ai][bj][m][n];
                        v[0] = __builtin_amdgcn_exp2f(v[0] - mrow); v[1] = __builtin_amdgcn_exp2f(v[1] - mrow); v[2] = __builtin_amdgcn_exp2f(v[2] - mrow); v[3] = __builtin_amdgcn_exp2f(v[3] - mrow);
                        acc[ai][bj][m][n] = v; sm += (v[0] + v[1]) + (v[2] + v[3]); }
                sm += __shfl_xor(sm, 16); sm += __shfl_xor(sm, 32);
                if (fq == 0) PS[rl * 4 + wc] = sm; }
        asm volatile("s_waitcnt lgkmcnt(0)" ::: "memory"); __builtin_amdgcn_s_barrier(); asm volatile("" ::: "memory");
#pragma unroll
        for (int ai = 0; ai < 2; ++ai)
#pragma unroll
            for (int m = 0; m < 4; ++m) { const int rl = ai * HALF + wr * 64 + m * 16 + fr; const f32x4 s4 = *(const PG8_LAS f32x4*)(PS + rl * 4);
                const float inv = 1.0f / ((s4[0] + s4[1]) + (s4[2] + s4[3])); bf16_t* rowp = O + (size_t)(u.pm * BM + rl) * ldc + col0;
#pragma unroll
                for (int bj = 0; bj < 2; ++bj) { const f32x4 v0 = acc[ai][bj][m][0] * inv, v1 = acc[ai][bj][m][1] * inv;
                    u32x4 w; w.x = cvt_pk_bf16(v0[0], v0[1]); w.y = cvt_pk_bf16(v0[2], v0[3]); w.z = cvt_pk_bf16(v1[0], v1[1]); w.w = cvt_pk_bf16(v1[2], v1[3]);
                    *(u32x4*)(rowp + bj * HALF) = w; } }
        (void)row0;
    }
};
__device__ __forceinline__ float silu_f(float x) { return x * __builtin_amdgcn_rcpf(1.0f + __builtin_amdgcn_exp2f(-1.44269504089f * x)); }
struct EpiSwiglu {
    static constexpr bool PERM = true, AFTER_DRAIN = false;
    bf16_t* O; int ldc; const float* rs;
    __device__ __forceinline__ void operator()(const f32x4 (&acc)[2][2][4][2], const Unit& u, int wr, int wc, int fr, int fq) const {
        const int row0 = u.pm * BM + wr * 64 + fr; const int col0 = u.pn * HALF + wc * 32 + 8 * fq;
#pragma unroll
        for (int ai = 0; ai < 2; ++ai)
#pragma unroll
            for (int m = 0; m < 4; ++m) { bf16_t* rowp = O + (size_t)(row0 + ai * HALF + m * 16) * ldc + col0;
                const float rr = rs[row0 + ai * HALF + m * 16];
                const f32x4 g0 = acc[ai][0][m][0] * rr, g1 = acc[ai][0][m][1] * rr, u0 = acc[ai][1][m][0] * rr, u1 = acc[ai][1][m][1] * rr;
                u32x4 w;
                w.x = cvt_pk_bf16(silu_f(g0[0]) * u0[0], silu_f(g0[1]) * u0[1]); w.y = cvt_pk_bf16(silu_f(g0[2]) * u0[2], silu_f(g0[3]) * u0[3]);
                w.z = cvt_pk_bf16(silu_f(g1[0]) * u1[0], silu_f(g1[1]) * u1[1]); w.w = cvt_pk_bf16(silu_f(g1[2]) * u1[2], silu_f(g1[3]) * u1[3]);
                *(u32x4*)rowp = w; }
    }
};

template <class Epi, class Sched, bool ALIGN_EPI = false, bool SP2 = false>
__device__ __forceinline__ void gemm_phase(PG8_LAS unsigned char* lds, const Gemm g, const Sched& S, const Epi& E) {
    const int tid = threadIdx.x, wid = __builtin_amdgcn_readfirstlane(tid >> 6), lane = tid & 63, wr = wid >> 2, wc = wid & 3, fr = lane & 15, fq = lane >> 4;
    const int K = g.K, nt = K / BK;
    unsigned voffA[2], voffB[2];
#pragma unroll
    for (int i = 0; i < 2; ++i) { int R, C; stage_rc(tid * 16 + i * 8192, R, C); const int Rb = Epi::PERM ? ((R & ~31) + perm32(R & 31)) : R;
        voffA[i] = (unsigned)(R * g.lda + C) * 2u; voffB[i] = (unsigned)(Rb * g.ldb + C) * 2u; }
    const size_t kstep = (size_t)(BK * 2);
    const size_t hstepA = (size_t)HALF * g.lda * 2, hstepB = (size_t)HALF * g.ldb * 2;
    const size_t tstepA = 2 * hstepA, tstepB = 2 * hstepB;
#define PG8_BOFF(u) ((g.ppb ? (size_t)((u).pm / g.ppb) * g.bstrideB * 2 : (size_t)0) + (size_t)(u).pn * tstepB)
    const unsigned ldsw = (unsigned)wid * 1024u;
    const int aoff = lds_byte(wr * 64 + fr, fq * 8), boff = lds_byte(wc * 32 + fr, fq * 8);
#define PG8_SA(b, h) (((b) * 2 + (h)) * HTB)
#define PG8_SB(b, h) ((4 + (b) * 2 + (h)) * HTB)
#define PG8_STAGE(bufoff, gbase, voff) do { _Pragma("unroll") for (int _i = 0; _i < 2; ++_i) \
        __builtin_amdgcn_global_load_lds((const unsigned*)((const char*)(gbase) + (voff)[_i]), (PG8_LAS unsigned*)(lds + (bufoff) + ldsw + _i * 8192), 16, 0, 0); } while (0)
#define PG8_LDA(dst, b, h) do { _Pragma("unroll") for (int m = 0; m < 4; ++m) _Pragma("unroll") for (int k = 0; k < 2; ++k) dst[m][k] = *(const PG8_LAS bf16x8*)(lds + PG8_SA(b, h) + aoff + m * 2048 + k * 1024); } while (0)
#define PG8_LDB(dst, b, h) do { _Pragma("unroll") for (int n = 0; n < 2; ++n) _Pragma("unroll") for (int k = 0; k < 2; ++k) dst[n][k] = *(const PG8_LAS bf16x8*)(lds + PG8_SB(b, h) + boff + n * 2048 + k * 1024); } while (0)
#define PG8_MMA(ai, bj, At, Bt) do { __builtin_amdgcn_s_setprio(1); _Pragma("unroll") for (int m = 0; m < 4; ++m) _Pragma("unroll") for (int n = 0; n < 2; ++n) _Pragma("unroll") for (int k = 0; k < 2; ++k) \
        acc[ai][bj][m][n] = __builtin_amdgcn_mfma_f32_16x16x32_bf16(Bt[n][k], At[m][k], acc[ai][bj][m][n], 0, 0, 0); __builtin_amdgcn_s_setprio(0); } while (0)
#define PG8_WAIT_V(n) asm volatile("s_waitcnt vmcnt(" #n ")" ::: "memory")
#define PG8_WAIT_L(n) asm volatile("s_waitcnt lgkmcnt(" #n ")" ::: "memory")
#define PG8_BAR __builtin_amdgcn_s_barrier()
#define PG8_SCHED __builtin_amdgcn_sched_barrier(0)
    Unit cur, nxt; int ui = 0;
    if (!S.next(0, cur)) return;
    f32x4 acc[2][2][4][2];
#pragma unroll
    for (int a = 0; a < 2; ++a)
#pragma unroll
        for (int b = 0; b < 2; ++b)
#pragma unroll
            for (int m = 0; m < 4; ++m)
#pragma unroll
                for (int n = 0; n < 2; ++n) acc[a][b][m][n] = (f32x4){0.f, 0.f, 0.f, 0.f};
    bf16x8 At[4][2], B0[2][2], B1[2][2];
    const char* cA = (const char*)g.A + (size_t)cur.pm * tstepA; const char* cB = (const char*)g.Bt + PG8_BOFF(cur);
    S.a_ready(cur);
    if constexpr (SP2) {
        PG8_STAGE(PG8_SB(0, 0), cB, voffB); PG8_STAGE(PG8_SB(0, 1), cB + hstepB, voffB); PG8_STAGE(PG8_SA(0, 0), cA, voffA); PG8_STAGE(PG8_SA(0, 1), cA + hstepA, voffA);
        if (wr == 1) PG8_BAR;
        PG8_WAIT_V(2); PG8_BAR;
        PG8_STAGE(PG8_SB(1, 0), cB + kstep, voffB); PG8_STAGE(PG8_SA(1, 0), cA + kstep, voffA); PG8_STAGE(PG8_SB(1, 1), cB + hstepB + kstep, voffB);
        PG8_WAIT_V(6); PG8_BAR;
    } else {
        PG8_STAGE(PG8_SB(0, 0), cB, voffB); PG8_STAGE(PG8_SA(0, 0), cA, voffA); PG8_STAGE(PG8_SB(0, 1), cB + hstepB, voffB); PG8_STAGE(PG8_SA(0, 1), cA + hstepA, voffA);
        if (wr == 1) PG8_BAR;
        PG8_WAIT_V(4); PG8_BAR;
        PG8_STAGE(PG8_SB(1, 0), cB + kstep, voffB); PG8_STAGE(PG8_SA(1, 0), cA + kstep, voffA); PG8_STAGE(PG8_SB(1, 1), cB + hstepB + kstep, voffB);
        PG8_WAIT_V(6); PG8_BAR;
    }
    for (;;) {
        const bool has_next = S.next(ui + 1, nxt);
        const char* nA = has_next ? (const char*)g.A + (size_t)nxt.pm * tstepA : cA; const char* nB = has_next ? (const char*)g.Bt + PG8_BOFF(nxt) : cB;
        for (int t = 0; t < nt; t += 2) {
            const bool last = (t == nt - 2);
            const char* a1 = cA + (size_t)(t + 1) * kstep;
            const char* a2 = last ? nA : cA + (size_t)(t + 2) * kstep; const char* b2 = last ? nB : cB + (size_t)(t + 2) * kstep;
            const char* a3 = a2 + kstep; const char* b3 = b2 + kstep;
            if (last && has_next) S.a_ready(nxt);
            if constexpr (SP2) {
            PG8_LDB(B0, 0, 0); PG8_LDB(B1, 0, 1); PG8_SCHED; PG8_LDA(At, 0, 0); PG8_STAGE(PG8_SA(1, 1), a1 + hstepA, voffA);
            PG8_WAIT_V(8); PG8_WAIT_L(0); PG8_BAR; PG8_MMA(0, 0, At, B0); PG8_MMA(0, 1, At, B1); PG8_BAR; PG8_SCHED;
            PG8_LDA(At, 0, 1); PG8_STAGE(PG8_SB(0, 0), b2, voffB); PG8_STAGE(PG8_SB(0, 1), b2 + hstepB, voffB); PG8_STAGE(PG8_SA(0, 0), a2, voffA);
            PG8_WAIT_V(8); PG8_WAIT_L(0); PG8_BAR; PG8_MMA(1, 0, At, B0); PG8_MMA(1, 1, At, B1); PG8_BAR; PG8_SCHED;
            PG8_LDB(B0, 1, 0); PG8_LDB(B1, 1, 1); PG8_SCHED; PG8_LDA(At, 1, 0); PG8_STAGE(PG8_SA(0, 1), a2 + hstepA, voffA);
            PG8_WAIT_V(8); PG8_WAIT_L(0); PG8_BAR; PG8_MMA(0, 0, At, B0); PG8_MMA(0, 1, At, B1); PG8_BAR; PG8_SCHED;
            PG8_LDA(At, 1, 1); PG8_STAGE(PG8_SB(1, 0), b3, voffB); PG8_STAGE(PG8_SB(1, 1), b3 + hstepB, voffB); PG8_STAGE(PG8_SA(1, 0), a3, voffA);
            PG8_WAIT_V(8); PG8_WAIT_L(0); PG8_BAR; PG8_MMA(1, 0, At, B0); PG8_MMA(1, 1, At, B1); PG8_BAR; PG8_SCHED;
            } else {
            PG8_LDB(B0, 0, 0); PG8_SCHED; PG8_LDA(At, 0, 0); PG8_STAGE(PG8_SA(1, 1), a1 + hstepA, voffA);
            PG8_WAIT_L(8); PG8_BAR; PG8_WAIT_L(0); PG8_MMA(0, 0, At, B0); PG8_BAR; PG8_SCHED;
            PG8_LDB(B1, 0, 1); PG8_STAGE(PG8_SB(0, 0), b2, voffB);
            PG8_BAR; PG8_WAIT_L(0); PG8_MMA(0, 1, At, B1); PG8_BAR;
            PG8_LDA(At, 0, 1); PG8_STAGE(PG8_SA(0, 0), a2, voffA);
            PG8_BAR; PG8_WAIT_L(0); PG8_MMA(1, 0, At, B0); PG8_BAR; PG8_SCHED;
            PG8_STAGE(PG8_SB(0, 1), b2 + hstepB, voffB);
            PG8_WAIT_V(6); PG8_BAR; PG8_MMA(1, 1, At, B1); PG8_BAR;
            PG8_LDB(B0, 1, 0); PG8_SCHED; PG8_LDA(At, 1, 0); PG8_STAGE(PG8_SA(0, 1), a2 + hstepA, voffA);
            PG8_WAIT_L(8); PG8_BAR; PG8_WAIT_L(0); PG8_MMA(0, 0, At, B0); PG8_BAR; PG8_SCHED;
            PG8_LDB(B1, 1, 1); PG8_STAGE(PG8_SB(1, 0), b3, voffB);
            PG8_BAR; PG8_WAIT_L(0); PG8_MMA(0, 1, At, B1); PG8_BAR;
            PG8_LDA(At, 1, 1); PG8_STAGE(PG8_SA(1, 0), a3, voffA);
            PG8_BAR; PG8_WAIT_L(0); PG8_MMA(1, 0, At, B0); PG8_BAR; PG8_SCHED;
            PG8_STAGE(PG8_SB(1, 1), b3 + hstepB, voffB);
            PG8_WAIT_V(6); PG8_BAR; PG8_MMA(1, 1, At, B1); PG8_BAR;
            }
        }
        if constexpr (ALIGN_EPI) { if (wr == 0) PG8_BAR; }
        if constexpr (!Epi::AFTER_DRAIN) { E(acc, cur, wr, wc, fr, fq); S.done(cur); }
        if (!has_next) break;
#pragma unroll
        for (int a = 0; a < 2; ++a)
#pragma unroll
            for (int b = 0; b < 2; ++b)
#pragma unroll
                for (int m = 0; m < 4; ++m)
#pragma unroll
                    for (int n = 0; n < 2; ++n) acc[a][b][m][n] = (f32x4){0.f, 0.f, 0.f, 0.f};
        cur = nxt; cA = nA; cB = nB; ++ui;
        if constexpr (ALIGN_EPI) { if (wr == 1) PG8_BAR; }
    }
    PG8_WAIT_V(0);
    if constexpr (!ALIGN_EPI) { if (wr == 0) PG8_BAR; }
    PG8_BAR;
    if constexpr (Epi::AFTER_DRAIN) { E.fused(acc, cur, wr, wc, fr, fq, lds, wid, lane); S.done(cur); }
#undef PG8_BOFF
#undef PG8_SA
#undef PG8_SB
#undef PG8_STAGE
#undef PG8_LDA
#undef PG8_LDB
#undef PG8_MMA
#undef PG8_WAIT_V
#undef PG8_WAIT_L
#undef PG8_BAR
#undef PG8_SCHED
}
}

namespace mk {
#define LAS __attribute__((address_space(3)))
#define DI __device__ __forceinline__
typedef unsigned short bf16_t;
typedef short bf16x8 __attribute__((ext_vector_type(8)));
typedef short bf16x4 __attribute__((ext_vector_type(4)));
typedef float f32x4 __attribute__((ext_vector_type(4)));
typedef float f32x2 __attribute__((ext_vector_type(2)));
typedef unsigned u32x4 __attribute__((ext_vector_type(4)));
typedef unsigned u32x2 __attribute__((ext_vector_type(2)));
typedef LAS unsigned char* ldsp;
#define MFMA16(a, b, c) __builtin_amdgcn_mfma_f32_16x16x32_bf16((a), (b), (c), 0, 0, 0)

constexpr int NB = 4, S = 8192, T = NB * S, D = 1024, INC = 2816, FF = 2816, NMEM = 256, MT = NB * NMEM;
constexpr int ZLD = 2304, ZQ = 0, ZK = 512, ZV = 640, ZRQ = 768, ZRK = 1280, ZRG = 1792;
constexpr float EPS = 1e-6f, LOG2E = 1.44269504089f;
constexpr size_t MiB = 1u << 20;
constexpr size_t WS_WIN = 1 * MiB, WS_WOUT = 7 * MiB, WS_WQ = 9 * MiB, WS_WKV = 11 * MiB, WS_WO = 15 * MiB, WS_WGU = 17 * MiB, WS_WDN = 28 * MiB;
constexpr size_t WS_ROPE64 = 34 * MiB, WS_ROPE128 = 36 * MiB, WS_MN = 40 * MiB, WS_KVM = 42 * MiB;
constexpr size_t WS_GT = 484 * MiB, WS_UT = 492 * MiB;
constexpr size_t WS_H = 48 * MiB, WS_Z = 112 * MiB, WS_VTR = 256 * MiB, WS_MIXCAT = 289 * MiB, WS_KVI = 354 * MiB, WS_PRV = 418 * MiB, WS_END = 500 * MiB;
constexpr int VTR_LD = T + 128, VTM_LD = MT + 128;
constexpr size_t WS_R0 = 33 * MiB + 512 * 1024, WS_R1 = WS_R0 + 131072, WS_R2 = WS_R1 + 131072;
constexpr size_t WS_ASQ = 47 * MiB;
constexpr size_t WS_XB = 418 * MiB;
constexpr size_t WS_MIXO = 112 * MiB, WS_Q = 176 * MiB, WS_AO = 289 * MiB, WS_XO = 112 * MiB, WS_F = 176 * MiB, WS_DN = 112 * MiB;
constexpr int LDS_BYTES = 147456;
constexpr int NPH = 14;
#ifndef REP_MASK
#define REP_MASK 0x0
#endif

struct Args { const float* in[21]; float* out; unsigned char* ws; int ph_lo, ph_hi; };

DI float bf2f(short v) { return __uint_as_float(((unsigned)(unsigned short)v) << 16); }
DI unsigned pk2(float lo, float hi) { return pg8::cvt_pk_bf16(lo, hi); }
DI float wave_sum(float v) {
#pragma unroll
    for (int o = 1; o < 64; o <<= 1) v += __shfl_xor(v, o);
    return v;
}
DI float ex2(float x) { return __builtin_amdgcn_exp2f(x); }

#define RLX_AGENT __ATOMIC_RELAXED, __HIP_MEMORY_SCOPE_AGENT
#define XB_TMO      128
#define XB_XCNT(j)  (256  + 64 * (j))
#define XB_XSUB(j)  (1280 + 64 * (j))
#define XB_XGEN(j)  (2304 + 64 * (j))
#define XB_TOP      3328
#define XB_TOPGEN   3392
#define XCD_BAR_WORDS 3456
#define XB_SPIN_CAP (1u << 18)

__device__ __forceinline__ unsigned xb_ld(unsigned* p)              { return __hip_atomic_load(p, __ATOMIC_RELAXED, __HIP_MEMORY_SCOPE_AGENT); }
__device__ __forceinline__ unsigned xb_add(unsigned* p, unsigned v) { return __hip_atomic_fetch_add(p, v, __ATOMIC_RELAXED, __HIP_MEMORY_SCOPE_AGENT); }
__device__ __forceinline__ unsigned xb_xcc_id() { return (unsigned)__builtin_amdgcn_s_getreg((3 << 11) | 20) & 0xFu; }
#define XB_SPIN(cond, bar) do { unsigned _sp = 0; while (cond) { __builtin_amdgcn_s_sleep(1); \
    if ((++_sp & 255u) == 0u) { if (xb_ld(&(bar)[XB_TMO])) break; if (_sp > XB_SPIN_CAP) { atomicAdd(&(bar)[XB_TMO], 1u); break; } } } } while (0)

struct XcdBarrier {
    unsigned* bar; unsigned x;
    volatile LAS unsigned* st;
};

__device__ __forceinline__ XcdBarrier xcd_barrier_post(unsigned* bar, volatile LAS unsigned* st) {
    XcdBarrier b; b.bar = bar; b.x = xb_xcc_id(); b.st = st;
    if (threadIdx.x == 0) (void)xb_add(&bar[XB_XCNT(b.x)], 1u);
    return b;
}
__device__ __forceinline__ void xcd_barrier_complete(unsigned* bar, unsigned x, unsigned& nloc, unsigned& nx) {
    const unsigned G = gridDim.x * gridDim.y * gridDim.z;
    unsigned sum, cnt, mine, sp = 0u;
    for (;;) {
        sum = 0u; cnt = 0u; mine = 0u;
#pragma unroll
        for (unsigned j = 0; j < 16; ++j) { const unsigned c = xb_ld(&bar[XB_XCNT(j)]); sum += c; cnt += (c > 0u) ? 1u : 0u; mine = (j == x) ? c : mine; }
        if (sum == G) break;
        __builtin_amdgcn_s_sleep(1);
        if ((++sp & 255u) == 0u) { if (xb_ld(&bar[XB_TMO])) break; if (sp > XB_SPIN_CAP) { atomicAdd(&bar[XB_TMO], 1u); break; } }
    }
    nloc = mine > 0u ? mine : 1u; nx = cnt > 0u ? cnt : 1u;
}

__device__ __forceinline__ void xcd_barrier(const XcdBarrier& b) {
    asm volatile("s_waitcnt vmcnt(0)" ::: "memory");
    __syncthreads();
    if (threadIdx.x == 0) {
        unsigned* bar = b.bar;
        __builtin_amdgcn_s_waitcnt(0);
        unsigned nloc = b.st[0], nx = b.st[1];
        if (nloc == 0u) { xcd_barrier_complete(bar, b.x, nloc, nx); b.st[0] = nloc; b.st[1] = nx; }
        const unsigned old = xb_add(&bar[XB_XSUB(b.x)], 1u);
        const unsigned gen = old / nloc;
        if (old + 1u == (gen + 1u) * nloc) {
            __builtin_amdgcn_fence(__ATOMIC_RELEASE, "agent");
            asm volatile("s_waitcnt vmcnt(0)" ::: "memory");
            const unsigned og = xb_add(&bar[XB_TOP], 1u);
            const unsigned tg = og / nx;
            if (og + 1u == (tg + 1u) * nx) xb_add(&bar[XB_TOPGEN], 1u);
            else XB_SPIN(xb_ld(&bar[XB_TOPGEN]) == tg, bar);
            __builtin_amdgcn_fence(__ATOMIC_ACQUIRE, "agent");
            xb_add(&bar[XB_XGEN(b.x)], 1u);
            asm volatile("s_waitcnt vmcnt(0)" ::: "memory");
        } else {
            XB_SPIN(xb_ld(&bar[XB_XGEN(b.x)]) == gen, bar);
            __builtin_amdgcn_fence(__ATOMIC_ACQUIRE, "agent");
            asm volatile("s_waitcnt vmcnt(0)" ::: "memory");
        }
    }
    __syncthreads();
}

DI void p0_transpose_item(const float* W, int K, int N, bf16_t* WT, int k0, int n0, int drow0, LAS float* scr, int lane, const float* wk) {
    float wv[32];
#pragma unroll
    for (int i = 0; i < 32; ++i) { const int kk = 2 * i + (lane >> 5); wv[i] = W[(size_t)(k0 + kk) * N + n0 + (lane & 31)]; }
    const float wk0 = wk ? wk[k0 + lane] : 1.0f;
#pragma unroll
    for (int i = 0; i < 32; ++i) { const int kk = 2 * i + (lane >> 5); scr[kk * 33 + (lane & 31)] = wv[i] * __shfl(wk0, kk); }
    asm volatile("s_waitcnt lgkmcnt(0)" ::: "memory");
    const int c = lane & 7;
#pragma unroll
    for (int j = 0; j < 4; ++j) { const int n = (lane >> 3) + 8 * j; const LAS float* s = scr + (8 * c) * 33 + n;
        u32x4 o; o.x = pk2(s[0 * 33], s[1 * 33]); o.y = pk2(s[2 * 33], s[3 * 33]); o.z = pk2(s[4 * 33], s[5 * 33]); o.w = pk2(s[6 * 33], s[7 * 33]);
        *(u32x4*)(WT + (size_t)(drow0 + n) * K + k0 + 8 * c) = o; }
    asm volatile("s_waitcnt lgkmcnt(0)" ::: "memory");
}
DI void p0_transpose(const float* W, int K, int N, bf16_t* WT, int item, bool gu, LAS float* scr, int lane, bool win = false, const float* wk = nullptr) {
    const int nblk = N / 32, kb = item / nblk, nb = item % nblk, n0 = 32 * nb;
    int dr = n0;
    if (win) { dr = n0 < 1792 ? n0 : (n0 < 2304 ? n0 + 512 : n0 - 512); }
    if (gu) { const int j = n0 < FF ? n0 : n0 - FF; dr = 256 * (j / 128) + (j % 128) + (n0 < FF ? 0 : 128); }
    p0_transpose_item(W, K, N, WT, 64 * kb, n0, dr, scr, lane, wk);
}
DI void rms_row_to_bf16(const float* xrow, const float* w, bf16_t* orow, int lane) {
    const f32x4* xr = (const f32x4*)xrow + lane; const f32x4* wr = (const f32x4*)w + lane;
    f32x4 v[4]; float s = 0.f;
#pragma unroll
    for (int j = 0; j < 4; ++j) { v[j] = xr[64 * j]; s += (v[j].x * v[j].x + v[j].y * v[j].y) + (v[j].z * v[j].z + v[j].w * v[j].w); }
    const float r = 1.0f / sqrtf(wave_sum(s) * (1.0f / D) + EPS);
    u32x2* o8 = (u32x2*)orow + lane;
#pragma unroll
    for (int j = 0; j < 4; ++j) { const f32x4 ww = wr[64 * j]; u32x2 o; o.x = pk2(v[j].x * r * ww.x, v[j].y * r * ww.y); o.y = pk2(v[j].z * r * ww.z, v[j].w * r * ww.w); o8[64 * j] = o; }
}
DI void p1_late_weights(const Args& a, ldsp lds, int gw, int NGW, int wave, int lane) {
    unsigned char* ws = a.ws; LAS float* scr = (LAS float*)(lds + wave * 16384);
    constexpr int I_SQ = 16 * 32, I_GU = 16 * 176, I_DN = 44 * 32;
    for (int it = gw; it < I_SQ + I_GU + I_DN; it += NGW) {
        int r = it;
        if (r < I_SQ) { p0_transpose(a.in[10], D, D, (bf16_t*)(ws + WS_WOUT), r, false, scr, lane); continue; } r -= I_SQ;
        if (r < I_GU) { p0_transpose(a.in[19], D, 2 * FF, (bf16_t*)(ws + WS_WGU), r, true, scr, lane, false, a.in[17]); continue; } r -= I_GU;
        p0_transpose(a.in[20], FF, D, (bf16_t*)(ws + WS_WDN), r, false, scr, lane);
    }
}
DI void row_copy_rs(const float* xrow, bf16_t* orow, float* rsp, int lane) {
    const f32x4* xr = (const f32x4*)xrow + lane; f32x4 v[4]; float s = 0.f;
#pragma unroll
    for (int j = 0; j < 4; ++j) { v[j] = xr[64 * j]; s += (v[j].x * v[j].x + v[j].y * v[j].y) + (v[j].z * v[j].z + v[j].w * v[j].w); }
    s = wave_sum(s);
    u32x2* o8 = (u32x2*)orow + lane;
#pragma unroll
    for (int j = 0; j < 4; ++j) { u32x2 o; o.x = pk2(v[j].x, v[j].y); o.y = pk2(v[j].z, v[j].w); o8[64 * j] = o; }
    if (lane == 0) *rsp = 1.0f / sqrtf(s * (1.0f / D) + EPS);
}
DI void p0_prologue(const Args& a, ldsp lds, int wave, int lane) {
    unsigned char* ws = a.ws;
    LAS float* scr = (LAS float*)(lds + wave * 16384);
    const int gw = blockIdx.x * 8 + wave, NGW = gridDim.x * 8;
    constexpr int I_IN = 16 * 88, I_SQ = 16 * 32, I_KV = 16 * 64;
    constexpr int NITEMS = I_IN + I_KV + I_SQ;
    for (int it = gw; it < NITEMS; it += NGW) {
        int r = it;
        if (r < I_IN) { p0_transpose(a.in[4], D, INC, (bf16_t*)(ws + WS_WIN), r, false, scr, lane, true, a.in[2]); continue; } r -= I_IN;
        if (r < I_KV) { p0_transpose(a.in[15], D, 2 * D, (bf16_t*)(ws + WS_WKV), r, false, scr, lane); continue; } r -= I_KV;
        p0_transpose(a.in[16], D, D, (bf16_t*)(ws + WS_WO), r, false, scr, lane);
    }
    {
        const int gt = blockIdx.x * 512 + threadIdx.x, NT = gridDim.x * 512;
        for (int e = gt; e < D * D / 4; e += NT) { const f32x4 v = ((const f32x4*)a.in[14])[e]; const float sc_ = a.in[11][e >> 8] * (0.0625f * LOG2E);
            u32x2 o; o.x = pk2(v.x * sc_, v.y * sc_); o.y = pk2(v.z * sc_, v.w * sc_); ((u32x2*)(ws + WS_WQ))[e] = o; }
    }
    {
        const int gt = blockIdx.x * 512 + threadIdx.x, NT = gridDim.x * 512;
        f32x2* r64 = (f32x2*)(ws + WS_ROPE64); f32x2* r128 = (f32x2*)(ws + WS_ROPE128);
        for (int e = gt; e < S * 96; e += NT) {
            const int s = e / 96, j = e % 96;
            const int i = j < 32 ? j : j - 32; const float dd = j < 32 ? 64.f : 128.f;
            const float inv_freq = powf(10000.0f, -(float)(2 * i) / dd);
            const float ang = (float)s * inv_freq;
            const double ad = (double)ang; const double nn = rint(ad * 0.15915494309189535); const float rr = (float)(ad - nn * 6.283185307179586);
            const f32x2 cs = {cosf(rr), sinf(rr)};
            if (j < 32) r64[s * 32 + i] = cs; else r128[s * 64 + i] = cs;
        }
    }
    for (int m = 2 * gw; m < T; m += 2 * NGW) {
        const f32x4* xr = (const f32x4*)(a.in[0] + (size_t)m * D) + lane; f32x4 v[8]; float s0 = 0.f, s1 = 0.f;
#pragma unroll
        for (int j = 0; j < 8; ++j) v[j] = __builtin_nontemporal_load(xr + 64 * j);
#pragma unroll
        for (int j = 0; j < 4; ++j) { s0 += (v[j].x * v[j].x + v[j].y * v[j].y) + (v[j].z * v[j].z + v[j].w * v[j].w); s1 += (v[4 + j].x * v[4 + j].x + v[4 + j].y * v[4 + j].y) + (v[4 + j].z * v[4 + j].z + v[4 + j].w * v[4 + j].w); }
        s0 = wave_sum(s0); s1 = wave_sum(s1);
        u32x2* o8 = (u32x2*)((bf16_t*)(ws + WS_H) + (size_t)m * D) + lane;
#pragma unroll
        for (int j = 0; j < 8; ++j) { u32x2 o; o.x = pk2(v[j].x, v[j].y); o.y = pk2(v[j].z, v[j].w); o8[64 * j] = o; }
        if (lane == 0) { float* rp = (float*)(ws + WS_R0) + m; rp[0] = 1.0f / sqrtf(s0 * (1.0f / D) + EPS); rp[1] = 1.0f / sqrtf(s1 * (1.0f / D) + EPS); }
    }
    for (int mm = gw; mm < MT; mm += NGW) rms_row_to_bf16(a.in[1] + (size_t)mm * D, a.in[13], (bf16_t*)(ws + WS_MN) + (size_t)mm * D, lane);
}

template <bool BASE_BF16, bool OUT_BF16, bool ASQ = false>
DI void rowwise_phase(const bf16_t* Y, const void* base, const float* wpost, void* outp, float* rnext, int wave, int lane, const float* asq = nullptr) {
    const int gw = blockIdx.x * 8 + wave, NGW = gridDim.x * 8;
    for (int row0 = 2 * gw; row0 < T; row0 += 2 * NGW) {
        u32x4 yu[2][2], bu[2][2]; f32x4 bf[2][2][2]; f32x4 q0[2], q1[2];
#pragma unroll
        for (int t = 0; t < 2; ++t) { const size_t row = (size_t)(row0 + t);
#pragma unroll
            for (int j = 0; j < 2; ++j) { yu[t][j] = __builtin_nontemporal_load((const u32x4*)(Y + row * D) + lane + 64 * j);
                if (BASE_BF16) bu[t][j] = ((const u32x4*)((const bf16_t*)base + row * D) + lane)[64 * j];
                else { const f32x4* bp = (const f32x4*)((const float*)base + row * D) + 2 * lane + 128 * j; bf[t][j][0] = bp[0]; bf[t][j][1] = bp[1]; } }
            if (ASQ) { q0[t] = *(const f32x4*)(asq + row * 8); q1[t] = *(const f32x4*)(asq + row * 8 + 4); } }
#pragma unroll
        for (int t = 0; t < 2; ++t) { const size_t row = (size_t)(row0 + t); float ss = 0.f; float y[2][8], bv[2][8];
#pragma unroll
            for (int j = 0; j < 2; ++j) { const unsigned yw[4] = {yu[t][j].x, yu[t][j].y, yu[t][j].z, yu[t][j].w};
#pragma unroll
                for (int e = 0; e < 4; ++e) { y[j][2 * e] = __uint_as_float(yw[e] << 16); y[j][2 * e + 1] = __uint_as_float(yw[e] & 0xffff0000u); }
                if (BASE_BF16) { const unsigned bw[4] = {bu[t][j].x, bu[t][j].y, bu[t][j].z, bu[t][j].w};
#pragma unroll
                    for (int e = 0; e < 4; ++e) { bv[j][2 * e] = __uint_as_float(bw[e] << 16); bv[j][2 * e + 1] = __uint_as_float(bw[e] & 0xffff0000u); } }
                else {
#pragma unroll
                    for (int e = 0; e < 4; ++e) { bv[j][e] = bf[t][j][0][e]; bv[j][4 + e] = bf[t][j][1][e]; } }
#pragma unroll
                for (int e = 0; e < 8; ++e) ss += y[j][e] * y[j][e]; }
            float eps_r = EPS;
            if (ASQ)
                eps_r = EPS * ((((q0[t].x + q0[t].y) + (q0[t].z + q0[t].w)) + ((q1[t].x + q1[t].y) + (q1[t].z + q1[t].w))) * (1.0f / 512.0f) + EPS);
            const float r = 1.0f / sqrtf(wave_sum(ss) * (1.0f / D) + eps_r);
            float s1 = 0.f;
#pragma unroll
            for (int j = 0; j < 2; ++j) { const f32x4* wp = (const f32x4*)wpost + 2 * lane + 128 * j; const f32x4 w0 = wp[0], w1 = wp[1]; float x1[8];
#pragma unroll
                for (int e = 0; e < 4; ++e) { x1[e] = bv[j][e] + y[j][e] * r * w0[e]; x1[4 + e] = bv[j][4 + e] + y[j][4 + e] * r * w1[e]; }
                if (OUT_BF16) { u32x4 o; o.x = pk2(x1[0], x1[1]); o.y = pk2(x1[2], x1[3]); o.z = pk2(x1[4], x1[5]); o.w = pk2(x1[6], x1[7]); ((u32x4*)((bf16_t*)outp + row * D) + lane)[64 * j] = o;
                    const unsigned ow[4] = {o.x, o.y, o.z, o.w};
#pragma unroll
                    for (int e = 0; e < 4; ++e) { x1[2 * e] = __uint_as_float(ow[e] << 16); x1[2 * e + 1] = __uint_as_float(ow[e] & 0xffff0000u); } }
                else { f32x4* op = (f32x4*)((float*)outp + row * D) + 2 * lane + 128 * j;
                    __builtin_nontemporal_store((f32x4){x1[0], x1[1], x1[2], x1[3]}, op); __builtin_nontemporal_store((f32x4){x1[4], x1[5], x1[6], x1[7]}, op + 1); }
#pragma unroll
                for (int e = 0; e < 8; ++e) s1 += x1[e] * x1[e]; }
            if (rnext) { s1 = wave_sum(s1); if (lane == 0) rnext[row] = 1.0f / sqrtf(s1 * (1.0f / D) + EPS); }
        }
    }
}

DI void rope8(bf16x8 lo, bf16x8 hi, const f32x2* tab, float sc, float (&o1)[8], float (&o2)[8]) {
    const f32x4* t4 = (const f32x4*)tab;
#pragma unroll
    for (int i = 0; i < 4; ++i) { const f32x4 cs = t4[i];
        { const float x1 = bf2f(lo[2 * i]), x2 = bf2f(hi[2 * i]); o1[2 * i] = (x1 * cs.x - x2 * cs.y) * sc; o2[2 * i] = (x1 * cs.y + x2 * cs.x) * sc; }
        { const float x1 = bf2f(lo[2 * i + 1]), x2 = bf2f(hi[2 * i + 1]); o1[2 * i + 1] = (x1 * cs.z - x2 * cs.w) * sc; o2[2 * i + 1] = (x1 * cs.w + x2 * cs.z) * sc; } }
}
DI void rope8t(bf16x8 lo, bf16x8 hi, const f32x4 (&t4)[4], float sc, float (&o1)[8], float (&o2)[8]) {
#pragma unroll
    for (int i = 0; i < 4; ++i) { const f32x4 cs = t4[i];
        { const float x1 = bf2f(lo[2 * i]), x2 = bf2f(hi[2 * i]); o1[2 * i] = (x1 * cs.x - x2 * cs.y) * sc; o2[2 * i] = (x1 * cs.y + x2 * cs.x) * sc; }
        { const float x1 = bf2f(lo[2 * i + 1]), x2 = bf2f(hi[2 * i + 1]); o1[2 * i + 1] = (x1 * cs.z - x2 * cs.w) * sc; o2[2 * i + 1] = (x1 * cs.w + x2 * cs.z) * sc; } }
}
DI bf16x8 pack8(const float (&v)[8]) { u32x4 w; w.x = pk2(v[0], v[1]); w.y = pk2(v[2], v[3]); w.z = pk2(v[4], v[5]); w.w = pk2(v[6], v[7]); return __builtin_bit_cast(bf16x8, w); }
DI bf16x8 pack44(f32x4 a, f32x4 b) { u32x4 w; w.x = pk2(a.x, a.y); w.y = pk2(a.z, a.w); w.z = pk2(b.x, b.y); w.w = pk2(b.z, b.w); return __builtin_bit_cast(bf16x8, w); }
DI bf16x8 ld8(const bf16_t* p) { return *(const bf16x8*)p; }
DI bf16x8 lds8(ldsp p) { return *(const LAS bf16x8*)p; }
DI bf16x8 lds44(ldsp p0, ldsp p1) { const bf16x4 a = *(const LAS bf16x4*)p0, b = *(const LAS bf16x4*)p1; return __builtin_shufflevector(a, b, 0, 1, 2, 3, 4, 5, 6, 7); }
DI void sts8(ldsp p, bf16x8 v) { *(LAS bf16x8*)p = v; }
DI void sts1(ldsp p, short v) { *(LAS short*)p = v; }
DI unsigned short f2bf1(float f) { return (unsigned short)(pk2(f, 0.f) & 0xffffu); }

constexpr int WA_KSTR = 144, WA_VSTR = 1040, WA_VOFF = 512 * WA_KSTR;
template <int QLO, int QHI>
DI void wa_chunk(ldsp lds, int kb, int ch, int half, int n, int fr, int fq, const bf16x8 (&qf)[4][2], f32x4 (&O)[4][4], float (&mrun)[4], float (&lsum)[4], const int (&klo_)[4], const int (&krng)[4]) {
                f32x4 sc[2][4];
#pragma unroll
                for (int kt = 0; kt < 2; ++kt)
#pragma unroll
                    for (int qt = QLO; qt < QHI; ++qt) sc[kt][qt] = (f32x4){0.f, 0.f, 0.f, 0.f};
#pragma unroll
                for (int kt = 0; kt < 2; ++kt)
#pragma unroll
                    for (int ks = 0; ks < 2; ++ks) { const bf16x8 kf = lds8(lds + (kb + ch * 32 + kt * 16 + fr) * WA_KSTR + ks * 64 + fq * 16);
#pragma unroll
                        for (int qt = QLO; qt < QHI; ++qt) sc[kt][qt] = MFMA16(kf, qf[qt][ks], sc[kt][qt]); }
                bf16x8 pf[4];
                const bool interior = (32 * ch >= 64 * half + 63) && (32 * ch + 31 <= 64 * half + 256) && (n > 0 || ch >= 4) && (n < 63 || ch < 8);
                if (!interior) {
#pragma unroll
                    for (int qt = QLO; qt < QHI; ++qt) {
                        const int t = ch * 32 + 4 * fq - klo_[qt];
#pragma unroll
                        for (int kt = 0; kt < 2; ++kt)
#pragma unroll
                            for (int i = 0; i < 4; ++i) sc[kt][qt][i] = ((unsigned)(t + kt * 16 + i) <= (unsigned)krng[qt]) ? sc[kt][qt][i] : -INFINITY; }
                }
#pragma unroll
                for (int qt = QLO; qt < QHI; ++qt) { float mx = -INFINITY;
#pragma unroll
                    for (int kt = 0; kt < 2; ++kt)
#pragma unroll
                        for (int i = 0; i < 4; ++i) mx = fmaxf(mx, sc[kt][qt][i]);
                    mx = fmaxf(mx, __shfl_xor(mx, 16)); mx = fmaxf(mx, __shfl_xor(mx, 32));
                    if (__builtin_amdgcn_ballot_w64(mx > mrun[qt] + 8.0f) != 0ull) {
                        const float mn = fmaxf(mrun[qt], mx), alpha = ex2(mrun[qt] - mn); mrun[qt] = mn; lsum[qt] *= alpha;
#pragma unroll
                        for (int dt = 0; dt < 4; ++dt) O[dt][qt] = O[dt][qt] * alpha; }
                    const float mn = mrun[qt]; float ps = 0.f;
#pragma unroll
                    for (int kt = 0; kt < 2; ++kt)
#pragma unroll
                        for (int i = 0; i < 4; ++i) { const float p = ex2(sc[kt][qt][i] - mn); sc[kt][qt][i] = p; ps += p; }
                    lsum[qt] += ps;
                    pf[qt] = pack44(sc[0][qt], sc[1][qt]); }
#pragma unroll
                for (int dt = 0; dt < 4; ++dt) { ldsp vp = lds + WA_VOFF + (dt * 16 + fr) * WA_VSTR + (kb + ch * 32 + 4 * fq) * 2; const bf16x8 vf = lds44(vp, vp + 32);
#pragma unroll
                    for (int qt = QLO; qt < QHI; ++qt) O[dt][qt] = MFMA16(vf, pf[qt], O[dt][qt]); }
            }

DI void wattn_phase(const Args& a, ldsp lds, int wave, int lane) {
    const bf16_t* Z = (const bf16_t*)(a.ws + WS_Z); bf16_t* MC = (bf16_t*)(a.ws + WS_MIXCAT);
    const f32x2* R64 = (const f32x2*)(a.ws + WS_ROPE64);
    const int tid = threadIdx.x, fr = lane & 15, fq = lane >> 4;
    for (int item = blockIdx.x; item < NB * 2 * 32; item += gridDim.x) {
        const int b = item >> 6, kvh = (item >> 5) & 1, n0 = 2 * (item & 31);
        __syncthreads();
        {
            int ts = tid; asm volatile("" : "+v"(ts));
            bf16x8 klo[4], khi[4], v0[4], v1[4]; f32x4 tb[4][4]; bool ok[4], okv[4];
#pragma unroll
            for (int k = 0; k < 4; ++k) { const int task = ts + 512 * k, r = task >> 2, c = task & 3, kpos = 128 * (n0 - 1) + r; ok[k] = (kpos >= 0 && kpos < S); const int kp = ok[k] ? kpos : 0;
                const bf16_t* p = Z + (size_t)(b * S + kp) * ZLD + ZK + kvh * 64 + 8 * c; klo[k] = ld8(p); khi[k] = ld8(p + 32);
                const f32x4* t4 = (const f32x4*)(R64 + kp * 32 + 8 * c);
#pragma unroll
                for (int i = 0; i < 4; ++i) tb[k][i] = t4[i]; }
#pragma unroll
            for (int k = 0; k < 4; ++k) { const int task = ts + 512 * k, p = task & 255, c = task >> 8, kpos = 128 * (n0 - 1) + 2 * p; okv[k] = (kpos >= 0 && kpos < S); const int kp = okv[k] ? kpos : 0;
                const bf16_t* vp = Z + (size_t)(b * S + kp) * ZLD + ZV + kvh * 64 + 8 * c; v0[k] = ld8(vp); v1[k] = ld8(vp + ZLD); }
#pragma unroll
            for (int k = 0; k < 4; ++k) { const int task = ts + 512 * k, r = task >> 2, c = task & 3; float o1[8], o2[8];
                rope8t(klo[k], khi[k], tb[k], ok[k] ? 1.0f : 0.0f, o1, o2);
                sts8(lds + r * WA_KSTR + 16 * c, pack8(o1)); sts8(lds + r * WA_KSTR + 64 + 16 * c, pack8(o2)); }
#pragma unroll
            for (int k = 0; k < 4; ++k) { const int task = ts + 512 * k, p = task & 255, c = task >> 8;
#pragma unroll
                for (int i = 0; i < 8; ++i) { const unsigned w = (unsigned)(unsigned short)v0[k][i] | ((unsigned)(unsigned short)v1[k][i] << 16);
                    *(LAS unsigned*)(lds + WA_VOFF + ((c >> 2) * 32 + 16 * (i >> 2) + 4 * (c & 3) + (i & 3)) * WA_VSTR + 4 * p) = okv[k] ? w : 0u; } }
        }
        __syncthreads();
        const int g = wave >> 1, half = wave & 1, head = kvh * 4 + g;
        const float sink2 = a.in[5][head] * LOG2E;
        for (int u2 = 0; u2 < 2; ++u2) {
            const int n = n0 + u2, kb = 128 * u2;
            bf16x8 qf[4][2];
#pragma unroll
            for (int qt = 0; qt < 4; ++qt) { const int spos = 128 * n + 64 * half + 16 * qt + fr;
                const bf16_t* p = Z + (size_t)(b * S + spos) * ZLD + ZQ + head * 64 + 8 * fq; float o1[8], o2[8];
                rope8(ld8(p), ld8(p + 32), R64 + spos * 32 + 8 * fq, 0.125f * LOG2E, o1, o2); qf[qt][0] = pack8(o1); qf[qt][1] = pack8(o2); }
            float mrun[4], lsum[4]; f32x4 O[4][4]; int klo_[4], krng[4];
#pragma unroll
            for (int qt = 0; qt < 4; ++qt) { const int qi = 64 * half + 16 * qt + fr; const int lo_ = max(qi, n == 0 ? 128 : 0), hi_ = min(qi + 256, n == 63 ? 255 : 383); klo_[qt] = lo_; krng[qt] = hi_ - lo_; }
#pragma unroll
            for (int qt = 0; qt < 4; ++qt) { mrun[qt] = sink2; lsum[qt] = (fq == 0) ? 1.0f : 0.0f;
#pragma unroll
                for (int dt = 0; dt < 4; ++dt) O[dt][qt] = (f32x4){0.f, 0.f, 0.f, 0.f}; }
            wa_chunk<0, 2>(lds, kb, 2 * half, half, n, fr, fq, qf, O, mrun, lsum, klo_, krng);
            for (int ch = 2 * half + 1; ch < 2 * half + 9; ++ch) wa_chunk<0, 4>(lds, kb, ch, half, n, fr, fq, qf, O, mrun, lsum, klo_, krng);
            wa_chunk<2, 4>(lds, kb, 2 * half + 9, half, n, fr, fq, qf, O, mrun, lsum, klo_, krng);
#pragma unroll
            for (int qt = 0; qt < 4; ++qt) { float l = lsum[qt]; l += __shfl_xor(l, 16); l += __shfl_xor(l, 32); const float inv = 1.0f / l;
                const int spos = 128 * n + 64 * half + 16 * qt + fr; bf16_t* op = MC + (size_t)(b * S + spos) * D + head * 64 + 8 * fq; float sq = 0.f;
#pragma unroll
                for (int j = 0; j < 2; ++j) { f32x4 o0 = O[2 * j][qt] * inv, o1 = O[2 * j + 1][qt] * inv;
                    sq += ((o0.x * o0.x + o0.y * o0.y) + (o0.z * o0.z + o0.w * o0.w)) + ((o1.x * o1.x + o1.y * o1.y) + (o1.z * o1.z + o1.w * o1.w));
                    o0 = o0 * *(const f32x4*)(a.in[6] + head * 64 + 32 * j + 8 * fq); o1 = o1 * *(const f32x4*)(a.in[6] + head * 64 + 32 * j + 8 * fq + 4);
                    u32x4 w; w.x = pk2(o0.x, o0.y); w.y = pk2(o0.z, o0.w); w.z = pk2(o1.x, o1.y); w.w = pk2(o1.z, o1.w); *(u32x4*)(op + 32 * j) = w; }
                sq += __shfl_xor(sq, 16); sq += __shfl_xor(sq, 32);
                if (fq == 0) ((float*)(a.ws + WS_ASQ))[(size_t)(b * S + spos) * 8 + head] = sq; }
        }
    }
}

constexpr int RT_STR = 272;
constexpr int RT_TILE = 128 * RT_STR;
DI void ret_lg2(const Args& a, int h, float& l2f, float& l2b) {
    l2f = -log1pf(expf(-a.in[7][h])) * LOG2E; l2b = -log1pf(expf(-a.in[8][h])) * LOG2E;
}
DI void ret_ld_vt(const bf16_t* VTR, int b, int h, int n, int tid, bf16x8 (&v)[4]) {
#pragma unroll
    for (int k = 0; k < 4; ++k) { const int task = tid + 512 * k, r = task >> 4, c = task & 15; v[k] = ld8(VTR + (size_t)(h * 128 + r) * VTR_LD + b * S + 128 * n + 8 * c); }
}
DI void ret_ld_tile(const bf16_t* src, int tid, bf16x8 (&v)[4]) {
#pragma unroll
    for (int k = 0; k < 4; ++k) { const int task = tid + 512 * k, r = task >> 4, c = task & 15; v[k] = ld8(src + r * 128 + 8 * c); }
}
template <bool PERM = false>
DI void ret_st_tile(ldsp dst, int tid, const bf16x8 (&v)[4]) {
#pragma unroll
    for (int k = 0; k < 4; ++k) { const int task = tid + 512 * k, r = task >> 4, c = task & 15; const int sl = PERM ? (r & ~31) + 16 * ((r >> 2) & 1) + 4 * ((r >> 3) & 3) + (r & 3) : r;
        sts8(dst + sl * RT_STR + 16 * c, v[k]); }
}
DI void ret_kv_phase(const Args& a, ldsp lds, int wave, int lane) {
    const bf16_t* Z = (const bf16_t*)(a.ws + WS_Z); const bf16_t* VTR = (const bf16_t*)(a.ws + WS_VTR); bf16_t* KVI = (bf16_t*)(a.ws + WS_KVI);
    const f32x2* R128 = (const f32x2*)(a.ws + WS_ROPE128);
    const int tid = threadIdx.x, fr = lane & 15, fq = lane >> 4;
    constexpr int NU = NB * 4 * 64;
    const int p = tid & 63, c = tid >> 6;
    bf16x8 vv[4], k0lo, k0hi, k1lo, k1hi; f32x4 tb0[4], tb1[4];
#define RKV_LOAD(u) do { const int b_ = (u) >> 8, h_ = ((u) >> 6) & 3, n_ = (u) & 63, sp_ = 128 * n_ + 2 * p; \
        ret_ld_vt(VTR, b_, h_, n_, tid, vv); \
        const bf16_t* kp_ = Z + (size_t)(b_ * S + sp_) * ZLD + ZRK + h_ * 128 + 8 * c; k0lo = ld8(kp_); k0hi = ld8(kp_ + 64); k1lo = ld8(kp_ + ZLD); k1hi = ld8(kp_ + ZLD + 64); \
        const f32x4* t0_ = (const f32x4*)(R128 + sp_ * 64 + 8 * c); const f32x4* t1_ = (const f32x4*)(R128 + (sp_ + 1) * 64 + 8 * c); \
        _Pragma("unroll") for (int i_ = 0; i_ < 4; ++i_) { tb0[i_] = t0_[i_]; tb1[i_] = t1_[i_]; } } while (0)
    int unit = blockIdx.x;
    if (unit < NU) RKV_LOAD(unit);
    for (; unit < NU; unit += gridDim.x) {
        const int b = unit >> 8, h = (unit >> 6) & 3, n = unit & 63;
        float l2f, l2b; ret_lg2(a, h, l2f, l2b);
        __syncthreads();
        {
            float a1[8], a2[8], b1[8], b2[8];
            rope8t(k0lo, k0hi, tb0, 0.08838834764831845f, a1, a2); rope8t(k1lo, k1hi, tb1, 0.08838834764831845f, b1, b2);
            const float wf0 = ex2((float)(127 - 2 * p) * l2f), wf1 = ex2((float)(126 - 2 * p) * l2f), wb0 = ex2((float)(2 * p) * l2b), wb1 = ex2((float)(2 * p + 1) * l2b);
#pragma unroll
            for (int i = 0; i < 8; ++i) {
                const int sl = (c >> 2) * 32 + 16 * (i >> 2) + 4 * (c & 3) + (i & 3);
                *(LAS unsigned*)(lds + RT_TILE + sl * RT_STR + 4 * p) = pk2(a1[i] * wf0, b1[i] * wf1); *(LAS unsigned*)(lds + RT_TILE + (64 + sl) * RT_STR + 4 * p) = pk2(a2[i] * wf0, b2[i] * wf1);
                *(LAS unsigned*)(lds + 2 * RT_TILE + sl * RT_STR + 4 * p) = pk2(a1[i] * wb0, b1[i] * wb1); *(LAS unsigned*)(lds + 2 * RT_TILE + (64 + sl) * RT_STR + 4 * p) = pk2(a2[i] * wb0, b2[i] * wb1); }
        }
        ret_st_tile(lds, tid, vv);
        __syncthreads();
        { const int nu = unit + (int)gridDim.x; if (nu < NU) RKV_LOAD(nu); }
        const int dkb = (wave & 3) * 32, dvb = (wave >> 2) * 64;
        f32x4 acc[2][2][4];
#pragma unroll
        for (int d = 0; d < 2; ++d)
#pragma unroll
            for (int x = 0; x < 2; ++x)
#pragma unroll
                for (int t = 0; t < 4; ++t) acc[d][x][t] = (f32x4){0.f, 0.f, 0.f, 0.f};
#pragma unroll
        for (int ks = 0; ks < 4; ++ks) {
            bf16x8 kf[2][2];
#pragma unroll
            for (int d = 0; d < 2; ++d)
#pragma unroll
                for (int x = 0; x < 2; ++x) kf[d][x] = lds8(lds + (1 + d) * RT_TILE + (dkb + 16 * x + fr) * RT_STR + ks * 64 + fq * 16);
#pragma unroll
            for (int t = 0; t < 4; ++t) { const bf16x8 vf = lds8(lds + (dvb + 16 * t + fr) * RT_STR + ks * 64 + fq * 16);
#pragma unroll
                for (int d = 0; d < 2; ++d)
#pragma unroll
                    for (int x = 0; x < 2; ++x) acc[d][x][t] = MFMA16(kf[d][x], vf, acc[d][x][t]); }
        }
#pragma unroll
        for (int d = 0; d < 2; ++d) { bf16_t* sp = KVI + ((size_t)(((b * 4 + h) * 2 + d) * 64 + n)) * 16384;
#pragma unroll
            for (int t = 0; t < 4; ++t) { u32x4 w; w.x = pk2(acc[d][0][t].x, acc[d][0][t].y); w.y = pk2(acc[d][0][t].z, acc[d][0][t].w); w.z = pk2(acc[d][1][t].x, acc[d][1][t].y); w.w = pk2(acc[d][1][t].z, acc[d][1][t].w);
                *(u32x4*)(sp + (dvb + 16 * t + fr) * 128 + dkb + 8 * fq) = w; } }
    }
#undef RKV_LOAD
}
DI void scan_phase(const Args& a, int wave, int lane) {
    const int gt = blockIdx.x * 512 + threadIdx.x, NT = gridDim.x * 512;
    for (int idx = gt; idx < 32 * 4096; idx += NT) {
        const int bhd = idx >> 12, e4 = idx & 4095, dir = bhd & 1, h = (bhd >> 1) & 3;
        float l2f, l2b; ret_lg2(a, h, l2f, l2b);
        const float decay = ex2(128.0f * (dir ? l2b : l2f));
        const u32x2* src = (const u32x2*)(a.ws + WS_KVI) + (size_t)bhd * 64 * 4096 + e4;
        u32x2* dst = (u32x2*)(a.ws + WS_PRV) + (size_t)bhd * 64 * 4096 + e4;
        f32x4 st = {0.f, 0.f, 0.f, 0.f};
        for (int it = 0; it < 64; it += 16) {
            u32x2 kv[16];
#pragma unroll
            for (int j = 0; j < 16; ++j) { const int n = dir ? 63 - (it + j) : it + j; kv[j] = src[(size_t)n * 4096]; }
#pragma unroll
            for (int j = 0; j < 16; ++j) { const int n = dir ? 63 - (it + j) : it + j; u32x2 o; o.x = pk2(st.x, st.y); o.y = pk2(st.z, st.w); dst[(size_t)n * 4096] = o;
                const f32x4 k4 = {__uint_as_float(kv[j].x << 16), __uint_as_float(kv[j].x & 0xffff0000u), __uint_as_float(kv[j].y << 16), __uint_as_float(kv[j].y & 0xffff0000u)};
                st = st * decay + k4; }
        }
    }
}
DI void anorm_phase(const Args& a, int wave, int lane) {
    bf16_t* MC = (bf16_t*)(a.ws + WS_MIXCAT);
    const int gw = blockIdx.x * 8 + wave, NGW = gridDim.x * 8;
    for (int row = gw; row < T; row += NGW) {
        bf16_t* p = MC + (size_t)row * D + 8 * lane; const bf16x8 v = ld8(p); float x[8], ss = 0.f;
#pragma unroll
        for (int i = 0; i < 8; ++i) { x[i] = bf2f(v[i]); ss += x[i] * x[i]; }
        const float r = 1.0f / sqrtf(wave_sum(ss) * (1.0f / 512.0f) + EPS);
        const f32x4 w0 = *(const f32x4*)(a.in[6] + 8 * lane), w1 = *(const f32x4*)(a.in[6] + 8 * lane + 4);
        x[0] *= r * w0.x; x[1] *= r * w0.y; x[2] *= r * w0.z; x[3] *= r * w0.w; x[4] *= r * w1.x; x[5] *= r * w1.y; x[6] *= r * w1.z; x[7] *= r * w1.w;
        *(bf16x8*)p = pack8(x);
    }
}
DI void ret_out_phase(const Args& a, ldsp lds, int wave, int lane) {
    const bf16_t* Z = (const bf16_t*)(a.ws + WS_Z); const bf16_t* VTR = (const bf16_t*)(a.ws + WS_VTR); const bf16_t* PRV = (const bf16_t*)(a.ws + WS_PRV); bf16_t* MC = (bf16_t*)(a.ws + WS_MIXCAT);
    const f32x2* R128 = (const f32x2*)(a.ws + WS_ROPE128);
    const int tid = threadIdx.x, fr = lane & 15, fq = lane >> 4;
    constexpr int NU = NB * 4 * 64;
    bf16x8 vv[4], pf_[4], pb_[4], klo[2], khi[2];
#define ROUT_LOAD(u) do { const int b_ = (u) >> 8, h_ = ((u) >> 6) & 3, n_ = (u) & 63; int tl_ = tid; asm volatile("" : "+v"(tl_)); \
        ret_ld_vt(VTR, b_, h_, n_, tl_, vv); \
        ret_ld_tile(PRV + ((size_t)(((b_ * 4 + h_) * 2 + 0) * 64 + n_)) * 16384, tl_, pf_); ret_ld_tile(PRV + ((size_t)(((b_ * 4 + h_) * 2 + 1) * 64 + n_)) * 16384, tl_, pb_); \
        _Pragma("unroll") for (int k_ = 0; k_ < 2; ++k_) { const int task_ = tl_ + 512 * k_, r_ = task_ >> 3, c_ = task_ & 7; \
            const bf16_t* p_ = Z + (size_t)(b_ * S + 128 * n_ + r_) * ZLD + ZRK + h_ * 128 + 8 * c_; klo[k_] = ld8(p_); khi[k_] = ld8(p_ + 64); } } while (0)
    int unit = blockIdx.x;
    if (unit < NU) ROUT_LOAD(unit);
    for (; unit < NU; unit += gridDim.x) {
        const int b = unit >> 8, h = (unit >> 6) & 3, n = unit & 63;
        float l2f, l2b; ret_lg2(a, h, l2f, l2b);
        {
            int ts = tid; asm volatile("" : "+v"(ts));
            f32x4 tb[2][4];
#pragma unroll
            for (int k = 0; k < 2; ++k) { const int task = ts + 512 * k, r = task >> 3, c = task & 7; const f32x4* t4 = (const f32x4*)(R128 + (128 * n + r) * 64 + 8 * c);
#pragma unroll
                for (int i = 0; i < 4; ++i) tb[k][i] = t4[i]; }
            __syncthreads();
            ret_st_tile<true>(lds + RT_TILE, ts, vv); ret_st_tile<true>(lds + 2 * RT_TILE, ts, pf_); ret_st_tile<true>(lds + 3 * RT_TILE, ts, pb_);
#pragma unroll
            for (int k = 0; k < 2; ++k) { const int task = ts + 512 * k, r = task >> 3, c = task & 7; float o1[8], o2[8];
                rope8t(klo[k], khi[k], tb[k], 0.08838834764831845f, o1, o2);
                sts8(lds + r * RT_STR + 16 * c, pack8(o1)); sts8(lds + r * RT_STR + 128 + 16 * c, pack8(o2)); }
        }
        const int cl = 16 * wave + fr, spos = 128 * n + cl; const size_t row = (size_t)(b * S + spos);
        bf16x8 qf[4];
#pragma unroll
        for (int ks = 0; ks < 2; ++ks) { const bf16_t* p = Z + row * ZLD + ZRQ + h * 128 + 32 * ks + 8 * fq; float o1[8], o2[8];
            rope8(ld8(p), ld8(p + 64), R128 + spos * 64 + 32 * ks + 8 * fq, 1.0f, o1, o2); qf[ks] = pack8(o1); qf[ks + 2] = pack8(o2); }
        __syncthreads();
        { const int nu = unit + (int)gridDim.x; if (nu < NU) ROUT_LOAD(nu); }
        f32x4 st[8];
#pragma unroll
        for (int mt = 0; mt < 8; ++mt) { st[mt] = (f32x4){0.f, 0.f, 0.f, 0.f};
#pragma unroll
            for (int ks = 0; ks < 4; ++ks) st[mt] = MFMA16(lds8(lds + (16 * mt + fr) * RT_STR + ks * 64 + fq * 16), qf[ks], st[mt]); }
#pragma unroll
        for (int mt = 0; mt < 8; ++mt)
#pragma unroll
            for (int i = 0; i < 4; ++i) { const int m = 16 * mt + 4 * fq + i, dl = cl - m; const float w = dl >= 0 ? ex2((float)dl * l2f) : ex2((float)(-dl) * l2b); st[mt][i] *= w; }
        f32x4 y[8];
#pragma unroll
        for (int dt = 0; dt < 8; ++dt) y[dt] = (f32x4){0.f, 0.f, 0.f, 0.f};
#pragma unroll
        for (int s4 = 0; s4 < 4; ++s4) { const bf16x8 pf = pack44(st[2 * s4], st[2 * s4 + 1]);
#pragma unroll
            for (int dt = 0; dt < 8; ++dt) { ldsp vp = lds + RT_TILE + (16 * dt + fr) * RT_STR + (32 * s4 + 4 * fq) * 2; y[dt] = MFMA16(lds44(vp, vp + 32), pf, y[dt]); } }
        const float wF = ex2((float)(cl + 1) * l2f), wB = ex2((float)(128 - cl) * l2b);
#pragma unroll
        for (int d = 0; d < 2; ++d) { const float wq_ = d ? wB : wF; bf16x8 qs[4];
#pragma unroll
            for (int ks = 0; ks < 4; ++ks) { float t8[8];
#pragma unroll
                for (int i = 0; i < 8; ++i) t8[i] = bf2f(qf[ks][i]) * wq_;
                qs[ks] = pack8(t8); }
#pragma unroll
            for (int ks = 0; ks < 4; ++ks)
#pragma unroll
                for (int dt = 0; dt < 8; ++dt) y[dt] = MFMA16(lds8(lds + (2 + d) * RT_TILE + (16 * dt + fr) * RT_STR + ks * 64 + fq * 16), qs[ks], y[dt]); }
        float sm = 0.f;
#pragma unroll
        for (int dt = 0; dt < 8; ++dt) sm += (y[dt].x + y[dt].y) + (y[dt].z + y[dt].w);
        sm += __shfl_xor(sm, 16); sm += __shfl_xor(sm, 32);
        const float mu = sm * (1.0f / 128.0f); float vs = 0.f;
#pragma unroll
        for (int dt = 0; dt < 8; ++dt) { y[dt] = y[dt] - mu; vs += (y[dt].x * y[dt].x + y[dt].y * y[dt].y) + (y[dt].z * y[dt].z + y[dt].w * y[dt].w); }
        vs += __shfl_xor(vs, 16); vs += __shfl_xor(vs, 32);
        float rs = 1.0f / sqrtf(vs * (1.0f / 128.0f) + EPS);
        {
            const f32x4 q0 = *(const f32x4*)((const float*)(a.ws + WS_ASQ) + row * 8), q1 = *(const f32x4*)((const float*)(a.ws + WS_ASQ) + row * 8 + 4);
            rs *= sqrtf((((q0.x + q0.y) + (q0.z + q0.w)) + ((q1.x + q1.y) + (q1.z + q1.w))) * (1.0f / 512.0f) + EPS); }
#pragma unroll
        for (int j = 0; j < 4; ++j) { const int dv = h * 128 + 32 * j + 8 * fq;
            const u32x4 gu = *(const u32x4*)(Z + row * ZLD + ZRG + dv); const f32x4 gw0 = *(const f32x4*)(a.in[9] + dv), gw1 = *(const f32x4*)(a.in[9] + dv + 4);
            const float g0 = __uint_as_float(gu.x << 16), g1 = __uint_as_float(gu.x & 0xffff0000u), g2 = __uint_as_float(gu.y << 16), g3 = __uint_as_float(gu.y & 0xffff0000u);
            const float g4 = __uint_as_float(gu.z << 16), g5 = __uint_as_float(gu.z & 0xffff0000u), g6 = __uint_as_float(gu.w << 16), g7 = __uint_as_float(gu.w & 0xffff0000u);
            u32x4 w; w.x = pk2(pg8::silu_f(g0) * y[2 * j].x * rs * gw0.x, pg8::silu_f(g1) * y[2 * j].y * rs * gw0.y); w.y = pk2(pg8::silu_f(g2) * y[2 * j].z * rs * gw0.z, pg8::silu_f(g3) * y[2 * j].w * rs * gw0.w);
            w.z = pk2(pg8::silu_f(g4) * y[2 * j + 1].x * rs * gw1.x, pg8::silu_f(g5) * y[2 * j + 1].y * rs * gw1.y); w.w = pk2(pg8::silu_f(g6) * y[2 * j + 1].z * rs * gw1.z, pg8::silu_f(g7) * y[2 * j + 1].w * rs * gw1.w);
            *(u32x4*)(MC + row * D + 512 + dv) = w; }
    }
#undef ROUT_LOAD
}

template <class Epi> DI void run_gemm(ldsp lds, const bf16_t* A, const bf16_t* Bt, int M, int N, int K, const Epi& E, int boff = 0, int lda = 0, int ldb = 0, int ppb = 0, size_t bstrideB = 0) {
    pg8::Gemm g{A, Bt, M, N, K, lda ? lda : K, ldb ? ldb : K, ppb, bstrideB}; pg8::StaticOrder So; So.init(M, N, (int)gridDim.x, (int)((blockIdx.x + gridDim.x - boff) % gridDim.x));
    pg8::gemm_phase<Epi, pg8::StaticOrder, true, true>(lds, g, So, E);
}

__global__ void __launch_bounds__(512, 2) fwd_kernel(Args a) {
    extern __shared__ __attribute__((aligned(16))) unsigned char lds_raw[];
    cg::grid_group grid = cg::this_grid();
    ldsp lds = (ldsp)lds_raw;
    const int tid = threadIdx.x, lane = tid & 63, wave = __builtin_amdgcn_readfirstlane(tid >> 6);
    unsigned char* ws = a.ws;
    const int lo = a.ph_lo, hi = a.ph_hi;
    volatile LAS unsigned* bst = (volatile LAS unsigned*)(lds + LDS_BYTES - 64);
    if (tid < 16) bst[tid] = 0u;
    __syncthreads();
    XcdBarrier bar; bar.bar = (unsigned*)ws; bar.x = 0; bar.st = bst;
    if (hi - lo > 1) bar = xcd_barrier_post((unsigned*)ws, bst);
#define IN(k) (lo <= (k) && (k) < hi)
#define SEAM(k) do { if (IN(k) && IN((k) + 1)) xcd_barrier(bar); } while (0)
    if (lo == 0x7fffffff) grid.sync();
#define PH(k, ...) do { if (IN(k)) { { __syncthreads(); __VA_ARGS__; } } } while (0)
    PH(0, p0_prologue(a, lds, wave, lane));
    SEAM(0);
    PH(1, run_gemm(lds, (const bf16_t*)(ws + WS_H), (const bf16_t*)(ws + WS_WIN), T, ZLD, D, pg8::EpiBf16{(bf16_t*)(ws + WS_Z), ZLD, 1.0f, (const float*)(ws + WS_R0), nullptr});
          __syncthreads();
          run_gemm(lds, (const bf16_t*)(ws + WS_MN), (const bf16_t*)(ws + WS_WKV), MT, 2 * D, D, pg8::EpiBf16{(bf16_t*)(ws + WS_KVM), 2 * D, 1.0f, nullptr, nullptr}, 128);
          __syncthreads();
          run_gemm(lds, (const bf16_t*)(ws + WS_WIN) + (size_t)ZLD * D, (const bf16_t*)(ws + WS_H), 512, T, D, pg8::EpiBf16{(bf16_t*)(ws + WS_VTR), VTR_LD, 1.0f, nullptr, (const float*)(ws + WS_R0)});
          if (gridDim.x == 256 && blockIdx.x >= 160) { __syncthreads(); p1_late_weights(a, lds, (int)(blockIdx.x - 160) * 8 + wave, 96 * 8, wave, lane); }
          else if (gridDim.x != 256) { __syncthreads(); p1_late_weights(a, lds, (int)blockIdx.x * 8 + wave, (int)gridDim.x * 8, wave, lane); });
    SEAM(1);
    PH(2, if (blockIdx.x < 128) {
              const int ci = blockIdx.x >> 2, b_ = (ci >> 2) & 3, h_ = ci & 3; const bf16_t* kvm = (const bf16_t*)(ws + WS_KVM) + (size_t)(b_ * NMEM) * 2 * D + h_ * 256;
              if (ci < 16) run_gemm(lds, kvm, (const bf16_t*)(ws + WS_WQ) + h_ * 256, 256, D, 256, pg8::EpiBf16{(bf16_t*)(ws + WS_GT) + (size_t)(b_ * D + h_ * 256) * D, D, 1.0f, nullptr, nullptr}, 4 * ci, 2 * D, D);
              else run_gemm(lds, (const bf16_t*)(ws + WS_WO) + h_ * 256, kvm + D, D, 256, 256, pg8::EpiBf16{(bf16_t*)(ws + WS_UT) + (size_t)b_ * D * D + h_ * 256, D, 1.0f, nullptr, nullptr}, 4 * ci, D, 2 * D);
              __syncthreads(); }
          wattn_phase(a, lds, wave, lane); ret_kv_phase(a, lds, wave, lane));
    SEAM(2);
    PH(3, scan_phase(a, wave, lane));
    SEAM(3);
    PH(4, ret_out_phase(a, lds, wave, lane));
    SEAM(4);
    PH(5, run_gemm(lds, (const bf16_t*)(ws + WS_MIXCAT), (const bf16_t*)(ws + WS_WOUT), T, D, D, pg8::EpiBf16{(bf16_t*)(ws + WS_MIXO), D, 1.0f, nullptr, nullptr}));
    SEAM(5);
    PH(6, rowwise_phase<true, true, true>((const bf16_t*)(ws + WS_MIXO), ws + WS_H, a.in[3], ws + WS_XB, (float*)(ws + WS_R1), wave, lane, (const float*)(ws + WS_ASQ)));
    SEAM(6);
    PH(7, run_gemm(lds, (const bf16_t*)(ws + WS_XB), (const bf16_t*)(ws + WS_GT), T, D, D, pg8::EpiSoftmax{(bf16_t*)(ws + WS_Q), D, (const float*)(ws + WS_R1), lds + 131072}, 0, 0, 0, S / 256, (size_t)D * D));
    SEAM(7);
    PH(8, run_gemm(lds, (const bf16_t*)(ws + WS_Q), (const bf16_t*)(ws + WS_UT), T, D, D, pg8::EpiBf16{(bf16_t*)(ws + WS_XO), D, 1.0f, nullptr, nullptr}, 0, 0, 0, S / 256, (size_t)D * D));
    SEAM(9);
    PH(10, rowwise_phase<true, true>((const bf16_t*)(ws + WS_XO), ws + WS_XB, a.in[12], ws + WS_XB, (float*)(ws + WS_R2), wave, lane));
    SEAM(10);
    PH(11, run_gemm(lds, (const bf16_t*)(ws + WS_XB), (const bf16_t*)(ws + WS_WGU), T, 2 * FF, D, pg8::EpiSwiglu{(bf16_t*)(ws + WS_F), FF, (const float*)(ws + WS_R2)}));
    SEAM(11);
    PH(12, run_gemm(lds, (const bf16_t*)(ws + WS_F), (const bf16_t*)(ws + WS_WDN), T, D, FF, pg8::EpiBf16{(bf16_t*)(ws + WS_DN), D, 1.0f, nullptr, nullptr}));
    SEAM(12);
    PH(13, rowwise_phase<true, false>((const bf16_t*)(ws + WS_DN), ws + WS_XB, a.in[18], a.out, nullptr, wave, lane));
    PH(14, wattn_phase(a, lds, wave, lane)); PH(15, ret_kv_phase(a, lds, wave, lane)); PH(16, scan_phase(a, wave, lane)); PH(17, anorm_phase(a, wave, lane));
#undef PH
#undef IN
#undef SEAM
}
}

#ifndef MK_N_LAUNCHES
#define MK_N_LAUNCHES 1
#endif
extern "C" void kernel_launch(void* const* d_in, const int* in_sizes, int n_in, void* d_out, int out_size, void* d_ws, size_t ws_size, hipStream_t stream) {
    using namespace mk;
    static int grid = 0;
    if (grid == 0) {
        if (n_in != 21 || in_sizes[0] != T * D || out_size != T * D || ws_size < WS_END) { fprintf(stderr, "kernel_launch: unexpected shapes (n_in %d, in0 %d, out %d, ws %zu)\n", n_in, n_in > 0 ? in_sizes[0] : -1, out_size, ws_size); grid = -1; return; }
        int dev = 0, cus = 0, per_cu = 0;
        if (hipGetDevice(&dev) != hipSuccess || hipDeviceGetAttribute(&cus, hipDeviceAttributeMultiprocessorCount, dev) != hipSuccess) { grid = -1; return; }
        if (hipFuncSetAttribute((const void*)fwd_kernel, hipFuncAttributeMaxDynamicSharedMemorySize, LDS_BYTES) != hipSuccess) { fprintf(stderr, "kernel_launch: hipFuncSetAttribute failed\n"); grid = -1; return; }
        if (hipOccupancyMaxActiveBlocksPerMultiprocessor(&per_cu, (const void*)fwd_kernel, 512, LDS_BYTES) != hipSuccess || per_cu < 1) { fprintf(stderr, "kernel_launch: occupancy query says %d\n", per_cu); per_cu = 1; }
        (void)hipGetLastError();
        grid = cus;
    }
    if (grid < 0) return;
    Args a{};
    for (int i = 0; i < 21; ++i) a.in[i] = (const float*)d_in[i];
    a.out = (float*)d_out; a.ws = (unsigned char*)d_ws;
#if MK_N_LAUNCHES == 1
    a.ph_lo = 0; a.ph_hi = NPH;
    if (hipMemsetAsync(d_ws, 0, 16384, stream) != hipSuccess) { fprintf(stderr, "kernel_launch: memset of the barrier words failed\n"); return; }
    void* args[] = {&a};
    hipError_t e = hipLaunchCooperativeKernel((const void*)fwd_kernel, dim3(grid), dim3(512), args, LDS_BYTES, stream);
    if (e != hipSuccess) fprintf(stderr, "cooperative launch failed: %s (grid %d)\n", hipGetErrorString(e), grid);
#else
    for (int k = 0; k < NPH; ++k) { a.ph_lo = k; a.ph_hi = k + 1; hipLaunchKernelGGL(fwd_kernel, dim3(grid), dim3(512), LDS_BYTES, stream, a); }
    for (int k = 0; k < 18; ++k) if ((REP_MASK >> k) & 1) for (int rep = 0; rep < 4; ++rep) { a.ph_lo = k; a.ph_hi = k + 1; hipLaunchKernelGGL(fwd_kernel, dim3(grid), dim3(512), LDS_BYTES, stream, a); }
#endif
}
```
